# Optimizing an MI355X kernel written in HIP

```python
import math
import jax, jax.numpy as jnp
from jax import lax
import numpy as np

D_MODEL = 1024
BATCH = 2
SEQ = 8192
DEPTH = 2
DEC_BATCH = 16
DEC_SEQ = 2048
PAST_LEN = 128

HEAD_DIM = 64
D_MIX = D_MODEL
CHUNK = 128
A_WIDTH = D_MIX // 4
A_GROUPS = A_WIDTH // HEAD_DIM
A_GROUP_DIM = A_WIDTH // A_GROUPS
B_WIDTH = 3 * D_MIX // 8
B_HEADS = B_WIDTH // HEAD_DIM
C_WIDTH = 3 * D_MIX // 8
C_HEADS = C_WIDTH // HEAD_DIM
C_KV_HEADS = C_HEADS // 3
KV_WIDTH = C_KV_HEADS * HEAD_DIM
IN_DIM = 2 * A_WIDTH + 4 * B_WIDTH + C_WIDTH + 2 * KV_WIDTH
WINDOW = 128
ROT_DIM = HEAD_DIM // 4
ROPE_THETA = 500000.0
RET_THETA = 10000.0
D_FF = 2816
CONV_WIDTH = 3
EPS = 1e-6

kernel_name = 'hybrid_bidir_encoder_two_groups'


def _rmsnorm(x, g):
    xf = x.astype(jnp.float32)
    y = xf * lax.rsqrt(jnp.mean(xf * xf, axis=-1, keepdims=True) + EPS)
    return (y * g.astype(jnp.float32)).astype(x.dtype)


def _rope(x, rot_dim, theta):
    s = x.shape[1]
    half = rot_dim // 2
    freqs = jnp.exp(-math.log(theta) * jnp.arange(half, dtype=jnp.float32) * 2.0 / rot_dim)
    ang = jnp.arange(s, dtype=jnp.float32)[:, None] * freqs[None, :]
    cos = jnp.cos(ang)[:, None, :]
    sin = jnp.sin(ang)[:, None, :]
    x1 = x[..., :half].astype(jnp.float32)
    x2 = x[..., half:rot_dim].astype(jnp.float32)
    rest = x[..., rot_dim:].astype(jnp.float32)
    return jnp.concatenate([x1 * cos - x2 * sin, x1 * sin + x2 * cos, rest], axis=-1)


def _sgu(u, v, norm_g, w_s, b_s):
    bsz, s, _ = u.shape
    n = s // CHUNK
    u = jax.nn.gelu(u)
    v = jax.nn.gelu(v).reshape(bsz, s, A_GROUPS, A_GROUP_DIM)
    v = _rmsnorm(v, norm_g.reshape(A_GROUPS, A_GROUP_DIM))
    vc = v.reshape(bsz, n, CHUNK, A_GROUPS, A_GROUP_DIM)
    gate = jnp.einsum('gij,bnjgd->bnigd', w_s, vc) + b_s.T[None, None, :, :, None]
    return u * gate.reshape(bsz, s, A_WIDTH)


def _retention_dir(q, k, v, log_gamma, strict):
    bsz, _, c, h, dk = q.shape
    dv = v.shape[-1]
    pos = jnp.arange(c, dtype=jnp.float32)
    diff = pos[:, None] - pos[None, :]
    mask = (diff > 0) if strict else (diff >= 0)
    decay_in = jnp.where(mask[None], jnp.exp(jnp.maximum(diff, 0.0)[None] * log_gamma[:, None, None]), 0.0)
    scores = jnp.einsum('bnihd,bnjhd->bnhij', q, k) * decay_in
    y_inner = jnp.einsum('bnhij,bnjhe->bnihe', scores, v)
    k_dec = jnp.exp((c - 1 - pos)[:, None] * log_gamma[None, :])
    kv = jnp.einsum('bnjhd,bnjhe->bnhde', k * k_dec[None, None, :, :, None], v)
    chunk_decay = jnp.exp(c * log_gamma)[:, None, None]

    def step(state, kv_n):
        return chunk_decay * state + kv_n, state

    s0 = jnp.zeros((bsz, h, dk, dv), jnp.float32)
    _, s_prev = lax.scan(step, s0, jnp.moveaxis(kv, 1, 0))
    s_prev = jnp.moveaxis(s_prev, 0, 1)
    q_dec = jnp.exp((pos + 1.0)[:, None] * log_gamma[None, :])
    y_cross = jnp.einsum('bnihd,bnhde->bnihe', q * q_dec[None, None, :, :, None], s_prev)
    return y_inner + y_cross


def _retention(q, k, v, g, dec_f, dec_b):
    bsz, s, h, d = q.shape
    n = s // CHUNK
    q = _rope(q, HEAD_DIM, RET_THETA)
    k = _rope(k, HEAD_DIM, RET_THETA) * (HEAD_DIM ** -0.5)
    v = v.astype(jnp.float32)
    chunk = lambda t: t.reshape(bsz, n, CHUNK, h, d)
    flip = lambda t: chunk(t[:, ::-1])
    lg_f = jax.nn.log_sigmoid(dec_f.astype(jnp.float32))
    lg_b = jax.nn.log_sigmoid(dec_b.astype(jnp.float32))
    y_f = _retention_dir(chunk(q), chunk(k), chunk(v), lg_f, False).reshape(bsz, s, h, d)
    y_b = _retention_dir(flip(q), flip(k), flip(v), lg_b, True).reshape(bsz, s, h, d)[:, ::-1]
    y = y_f + y_b
    mu = jnp.mean(y, axis=-1, keepdims=True)
    var = jnp.mean(jnp.square(y - mu), axis=-1, keepdims=True)
    y = (y - mu) * lax.rsqrt(var + EPS)
    out = jax.nn.silu(g.astype(jnp.float32)) * y
    return out.reshape(bsz, s, B_WIDTH).astype(g.dtype)


def _window_gqa(q, k, v, sink):
    bsz, s, _, _ = q.shape
    n = s // CHUNK
    grp = C_HEADS // C_KV_HEADS
    q = _rope(q, ROT_DIM, ROPE_THETA)
    k = _rope(k, ROT_DIM, ROPE_THETA)
    qb = q.reshape(bsz, n, CHUNK, C_KV_HEADS, grp, HEAD_DIM)

    def band(t):
        tp = jnp.pad(t.astype(jnp.float32), ((0, 0), (CHUNK, CHUNK), (0, 0), (0, 0)))
        tp = tp.reshape(bsz, n + 2, CHUNK, C_KV_HEADS, HEAD_DIM)
        return jnp.concatenate([tp[:, :-2], tp[:, 1:-1], tp[:, 2:]], axis=2)

    kb = band(k)
    vb = band(v)
    sc = jnp.einsum('bnikgd,bnjkd->bnkgij', qb, kb) * (HEAD_DIM ** -0.5)
    blk = jnp.arange(n)[:, None, None]
    qpos = blk * CHUNK + jnp.arange(CHUNK)[None, :, None]
    kpos = (blk - 1) * CHUNK + jnp.arange(3 * CHUNK)[None, None, :]
    mask = (jnp.abs(kpos - qpos) <= WINDOW) & (kpos >= 0) & (kpos < s)
    sc = jnp.where(mask[None, :, None, None], sc, -jnp.inf)
    sk = sink.astype(jnp.float32).reshape(C_KV_HEADS, grp)[:, :, None, None]
    m = jnp.maximum(jnp.max(sc, axis=-1, keepdims=True), sk)
    p = jnp.exp(sc - m)
    denom = jnp.sum(p, axis=-1, keepdims=True) + jnp.exp(sk - m)
    o = jnp.einsum('bnkgij,bnjkd->bnikgd', p / denom, vb)
    return o.reshape(bsz, s, C_WIDTH)


def _token_mixers(h, w_in, sgu_norm, sgu_w, sgu_b, dec_f, dec_b, sink, w_out):
    bsz, s, _ = h.shape
    proj = h @ w_in
    sizes = [A_WIDTH, A_WIDTH, B_WIDTH, B_WIDTH, B_WIDTH, B_WIDTH, C_WIDTH, KV_WIDTH]
    points = list(np.cumsum(sizes))
    a_u, a_v, b_q, b_k, b_v, b_g, c_q, c_k, c_v = jnp.split(proj, points, axis=-1)
    y_a = _sgu(a_u, a_v, sgu_norm, sgu_w, sgu_b)
    hb = lambda t: t.reshape(bsz, s, B_HEADS, HEAD_DIM)
    y_b = _retention(hb(b_q), hb(b_k), hb(b_v), hb(b_g), dec_f, dec_b)
    y_c = _window_gqa(c_q.reshape(bsz, s, C_HEADS, HEAD_DIM),
                      c_k.reshape(bsz, s, C_KV_HEADS, HEAD_DIM),
                      c_v.reshape(bsz, s, C_KV_HEADS, HEAD_DIM), sink)
    y = jnp.concatenate([y_a, y_b, y_c], axis=-1).astype(h.dtype)
    return y @ w_out


def _conv_ffn(h, w_up, conv_w, conv_b, w_down):
    s = h.shape[1]
    up = h @ w_up
    pad = CONV_WIDTH // 2
    upp = jnp.pad(up, ((0, 0), (pad, pad), (0, 0)))
    conv = conv_b[None, None, :]
    for t in range(CONV_WIDTH):
        conv = conv + conv_w[t][None, None, :] * upp[:, t:t + s]
    gate, val = jnp.split(conv, 2, axis=-1)
    return (jax.nn.gelu(gate) * val) @ w_down


def _layer(x, c, w_ada, b_ada, g_pre_mix, g_post_mix, g_pre_ffn, g_post_ffn,
           w_in, sgu_norm, sgu_w, sgu_b, dec_f, dec_b, sink, w_out,
           w_up, conv_w, conv_b, w_down):
    mod = jax.nn.silu(c) @ w_ada + b_ada
    sh1, sc1, gt1, sh2, sc2, gt2 = [m[:, None, :] for m in jnp.split(mod, 6, axis=-1)]
    h = _rmsnorm(x, g_pre_mix) * (1.0 + sc1) + sh1
    y = _token_mixers(h, w_in, sgu_norm, sgu_w, sgu_b, dec_f, dec_b, sink, w_out)
    x = x + gt1 * _rmsnorm(y, g_post_mix)
    h = _rmsnorm(x, g_pre_ffn) * (1.0 + sc2) + sh2
    y = _conv_ffn(h, w_up, conv_w, conv_b, w_down)
    x = x + gt2 * _rmsnorm(y, g_post_ffn)
    return x


def setup_inputs(seed: int = 0) -> dict:
    key = jax.random.key(seed)
    ks = jax.random.split(key, 24)
    nrm = lambda k, shape, scale: scale * jax.random.normal(k, shape, jnp.float32)
    z0 = jnp.asarray(np.log(2.0 ** (5 + np.arange(B_HEADS)) - 1.0).astype(np.float32))
    return {
        'x_prompt': nrm(ks[0], (BATCH, SEQ, D_MODEL), 1.0),
        'x_sample': nrm(ks[1], (DEC_BATCH, DEC_SEQ, D_MODEL), 1.0),
        'c_prompt': nrm(ks[2], (BATCH, D_MODEL), 1.0),
        'c_sample': nrm(ks[3], (DEC_BATCH, D_MODEL), 1.0),
        'w_ada': nrm(ks[4], (DEPTH, D_MODEL, 6 * D_MODEL), D_MODEL ** -0.5),
        'b_ada': nrm(ks[5], (DEPTH, 6 * D_MODEL), 0.02),
        'norm_pre_mix': 1.0 + nrm(ks[6], (DEPTH, D_MODEL), 0.05),
        'norm_post_mix': 1.0 + nrm(ks[7], (DEPTH, D_MODEL), 0.05),
        'norm_pre_ffn': 1.0 + nrm(ks[8], (DEPTH, D_MODEL), 0.05),
        'norm_post_ffn': 1.0 + nrm(ks[9], (DEPTH, D_MODEL), 0.05),
        'w_in': nrm(ks[10], (DEPTH, D_MODEL, IN_DIM), D_MODEL ** -0.5),
        'sgu_norm': 1.0 + nrm(ks[11], (DEPTH, A_WIDTH), 0.05),
        'sgu_w': nrm(ks[12], (DEPTH, A_GROUPS, CHUNK, CHUNK), CHUNK ** -0.5),
        'sgu_b': 1.0 + nrm(ks[13], (DEPTH, A_GROUPS, CHUNK), 0.1),
        'ret_decay_fwd': z0[None, :] + nrm(ks[14], (DEPTH, B_HEADS), 0.05),
        'ret_decay_bwd': z0[None, :] + nrm(ks[15], (DEPTH, B_HEADS), 0.05),
        'attn_sink': nrm(ks[16], (DEPTH, C_HEADS), 0.5),
        'w_out': nrm(ks[17], (DEPTH, D_MIX, D_MODEL), D_MIX ** -0.5),
        'w_up': nrm(ks[18], (DEPTH, D_MODEL, 2 * D_FF), D_MODEL ** -0.5),
        'conv_w': nrm(ks[19], (DEPTH, CONV_WIDTH, 2 * D_FF), CONV_WIDTH ** -0.5),
        'conv_b': nrm(ks[20], (DEPTH, 2 * D_FF), 0.02),
        'w_down': nrm(ks[21], (DEPTH, D_FF, D_MODEL), D_FF ** -0.5),
    }


def reference(x_prompt, x_sample, c_prompt, c_sample, w_ada, b_ada,
              norm_pre_mix, norm_post_mix, norm_pre_ffn, norm_post_ffn,
              w_in, sgu_norm, sgu_w, sgu_b, ret_decay_fwd, ret_decay_bwd, attn_sink,
              w_out, w_up, conv_w, conv_b, w_down):
    y_prompt = x_prompt
    y_sample = x_sample
    for l in range(DEPTH):
        layer_params = (w_ada[l], b_ada[l], norm_pre_mix[l], norm_post_mix[l],
                        norm_pre_ffn[l], norm_post_ffn[l], w_in[l], sgu_norm[l],
                        sgu_w[l], sgu_b[l], ret_decay_fwd[l], ret_decay_bwd[l],
                        attn_sink[l], w_out[l], w_up[l], conv_w[l], conv_b[l], w_down[l])
        y_prompt = _layer(y_prompt, c_prompt, *layer_params)
        y_sample = _layer(y_sample, c_sample, *layer_params)
    return (y_prompt, y_sample)
```

```cpp
#include <hip/hip_runtime.h>
#include <hip/hip_cooperative_groups.h>
#include <cstdio>
#include <cstdint>
namespace cg = cooperative_groups;

#define EPI_VARIANT 0
#define PANEL_H 4
#ifndef N_LAUNCH_MODE
#define N_LAUNCH_MODE 1
#endif

typedef unsigned short bf16_t;
typedef __attribute__((ext_vector_type(8))) short bf16x8;
typedef __attribute__((ext_vector_type(16))) float f32x16;
typedef __attribute__((ext_vector_type(4))) float f32x4;
typedef __attribute__((ext_vector_type(4))) unsigned u32x4;
typedef __attribute__((ext_vector_type(2))) unsigned u32x2;

constexpr int D = 1024, T = 49152, TP = 16384, IN_DIM = 2688, DFF = 2816, NCH = 384, NB = 18, DEPTH = 2;
constexpr float EPS = 1e-6f;
constexpr int LDS_BYTES = 36864;
constexpr int DYN_LDS = 131072;

constexpr int NPHASE = 2 + 9 * DEPTH;

constexpr size_t SZ_WIN = (size_t)IN_DIM * D * 2, SZ_WOUT = (size_t)D * D * 2, SZ_WUP = (size_t)2 * DFF * D * 2, SZ_WDOWN = (size_t)D * DFF * 2, SZ_SGUW = 4 * 128 * 128 * 2;
constexpr size_t OFF_WIN = 0, OFF_WOUT = OFF_WIN + SZ_WIN, OFF_WUP = OFF_WOUT + SZ_WOUT, OFF_WDOWN = OFF_WUP + SZ_WUP, OFF_SGUW = OFF_WDOWN + SZ_WDOWN;
constexpr size_t SZ_WLAYER = OFF_SGUW + SZ_SGUW;
constexpr size_t OFF_MOD = SZ_WLAYER * DEPTH;
constexpr size_t OFF_ROPER_ = OFF_MOD + (size_t)DEPTH * NB * 6 * D * 4;
constexpr size_t OFF_ROPEA = OFF_ROPER_ + (size_t)8192 * 32 * 8;
constexpr size_t OFF_RA = OFF_ROPEA + (size_t)8192 * 8 * 8;
constexpr size_t OFF_RB = OFF_RA + (size_t)T * D * 2;
constexpr size_t OFF_RC = OFF_RB + (size_t)T * DFF * 2;
constexpr size_t WS_END = OFF_RC + (size_t)T * D * 2;
constexpr size_t OFF_ZERO = WS_END;
constexpr size_t OFF_BAR = WS_END + 8192;
constexpr size_t BAR_BYTES = 16384;
constexpr size_t WS_NEED = OFF_BAR + BAR_BYTES;

struct Params {
  const float *xp, *xs, *cp, *cs, *w_ada, *b_ada, *g_pre_mix, *g_post_mix, *g_pre_ffn, *g_post_ffn, *w_in, *sgu_norm, *sgu_w, *sgu_b,
      *dec_f, *dec_b, *sink, *w_out, *w_up, *conv_w, *conv_b, *w_down;
  float* out;
  unsigned char* ws;
};

__device__ __forceinline__ int tid_() { int t = threadIdx.x; asm volatile("" : "+v"(t)); return t; }
typedef __bf16 bf16x2_t __attribute__((ext_vector_type(2)));
typedef float f32x2_t __attribute__((ext_vector_type(2)));
__device__ __forceinline__ unsigned pack2(float lo, float hi) {
  f32x2_t v = {lo, hi};
  bf16x2_t b = __builtin_convertvector(v, bf16x2_t);
  return __builtin_bit_cast(unsigned, b);
}
__device__ __forceinline__ bf16_t f2bf(float f) { __bf16 b = (__bf16)f; return __builtin_bit_cast(unsigned short, b); }
__device__ __forceinline__ float bf2f(unsigned h) { return __uint_as_float(h << 16); }
__device__ __forceinline__ float bflo(unsigned u) { return __uint_as_float(u << 16); }
__device__ __forceinline__ float bfhi(unsigned u) { return __uint_as_float(u & 0xffff0000u); }
__device__ __forceinline__ float fexp2(float x) { return __builtin_amdgcn_exp2f(x); }
__device__ __forceinline__ float frcp(float x) { return __builtin_amdgcn_rcpf(x); }
__device__ __forceinline__ float gelu_t(float x) {
  const float u = 0.7978845608028654f * (x + 0.044715f * x * x * x);
  return x * frcp(1.f + fexp2(-2.885390081777927f * u));
}
__device__ __forceinline__ float silu_f(float x) { return x * frcp(1.f + fexp2(-1.4426950408889634f * x)); }
__device__ __forceinline__ float wave_sum(float v) {
#pragma unroll
  for (int o = 1; o < 64; o <<= 1) v += __shfl_xor(v, o);
  return v;
}
__device__ __forceinline__ float half_sum(float v) {
#pragma unroll
  for (int o = 1; o < 32; o <<= 1) v += __shfl_xor(v, o);
  return v;
}
__device__ __forceinline__ float half_max(float v) {
#pragma unroll
  for (int o = 1; o < 32; o <<= 1) v = fmaxf(v, __shfl_xor(v, o));
  return v;
}
__device__ __forceinline__ int pos_of(int t) { return t < TP ? (t & 8191) : ((t - TP) & 2047); }
__device__ __forceinline__ int batch_of(int t) { return t < TP ? (t >> 13) : 2 + ((t - TP) >> 11); }
__device__ __forceinline__ int crow(int reg, int lane) { return (reg & 3) + 8 * (reg >> 2) + 4 * (lane >> 5); }
__device__ __forceinline__ f32x16 mfma32(bf16x8 a, bf16x8 b, f32x16 c) { return __builtin_amdgcn_mfma_f32_32x32x16_bf16(a, b, c, 0, 0, 0); }
__device__ __forceinline__ f32x16 zero16() { f32x16 z;
#pragma unroll
  for (int i = 0; i < 16; ++i) z[i] = 0.f;
  return z; }

__device__ __forceinline__ void wave_lds_fence() { asm volatile("s_waitcnt lgkmcnt(0)" ::: "memory"); }
__device__ __forceinline__ void mma_rt(const bf16x8* afr, const bf16_t* sB, f32x16* acc, int lane) {
#pragma unroll
  for (int s = 0; s < 4; ++s) {
#pragma unroll
    for (int n2 = 0; n2 < 2; ++n2) {
      const bf16x8 b = *(const bf16x8*)(sB + (n2 * 32 + (lane & 31)) * 72 + s * 16 + (lane >> 5) * 8);
      acc[n2] = mfma32(afr[s], b, acc[n2]);
    }
  }
}
__device__ __forceinline__ void stage_rows_bf16(bf16_t* dst, const bf16_t* src, int ld) {
  const int t = tid_() & 255, r = t >> 2, q = t & 3;
  const u32x4* s = (const u32x4*)(src + (size_t)r * ld + q * 16);
  u32x4 a = s[0], b = s[1];
  u32x4* d = (u32x4*)(dst + r * 72 + q * 16);
  d[0] = a; d[1] = b;
}
__device__ __forceinline__ void stage_T_bf16(bf16_t* dst, const bf16_t* src, int ld, float rowscale) {
  const int t = tid_() & 255, j = t & 63, q = t >> 6;
  const u32x4* s = (const u32x4*)(src + (size_t)j * ld + q * 16);
  u32x4 a = s[0], b = s[1];
  unsigned w[8] = {a.x, a.y, a.z, a.w, b.x, b.y, b.z, b.w};
#pragma unroll
  for (int i = 0; i < 8; ++i) {
    dst[(q * 16 + 2 * i) * 72 + j] = f2bf(bflo(w[i]) * rowscale);
    dst[(q * 16 + 2 * i + 1) * 72 + j] = f2bf(bfhi(w[i]) * rowscale);
  }
}
__device__ __forceinline__ void ldg_rows(u32x4 (&r)[2], const bf16_t* src, int ld) {
  const int t = tid_() & 255, row = t >> 2, q = t & 3;
  const u32x4* s = (const u32x4*)(src + (size_t)row * ld + q * 16);
  r[0] = s[0]; r[1] = s[1];
}
__device__ __forceinline__ void sts_rows(bf16_t* dst, const u32x4 (&r)[2]) {
  const int t = tid_() & 255, row = t >> 2, q = t & 3;
  u32x4* d = (u32x4*)(dst + row * 72 + q * 16);
  d[0] = r[0]; d[1] = r[1];
}
__device__ __forceinline__ void sts_T(bf16_t* dst, const u32x4 (&r)[2], float rowscale) {
  const int t = tid_() & 255, j = t >> 2, q = t & 3;
  const unsigned w[8] = {r[0].x, r[0].y, r[0].z, r[0].w, r[1].x, r[1].y, r[1].z, r[1].w};
#pragma unroll
  for (int i = 0; i < 8; ++i) {
    dst[(q * 16 + 2 * i) * 72 + j] = f2bf(bflo(w[i]) * rowscale);
    dst[(q * 16 + 2 * i + 1) * 72 + j] = f2bf(bfhi(w[i]) * rowscale);
  }
}
__device__ __forceinline__ void ldg_rowsT(u32x4 (&r)[2], const bf16_t* src, int ld) {
  const int t = tid_() & 255, row = t & 63, q = t >> 6;
  const u32x4* s = (const u32x4*)(src + (size_t)row * ld + q * 16);
  r[0] = s[0]; r[1] = s[1];
}
__device__ __forceinline__ void sts_T_raw(bf16_t* dst, const u32x4 (&r)[2]) {
  const int t = tid_() & 255, j = t & 63, q = t >> 6;
  const unsigned w[8] = {r[0].x, r[0].y, r[0].z, r[0].w, r[1].x, r[1].y, r[1].z, r[1].w};
#pragma unroll
  for (int i = 0; i < 8; ++i) {
    dst[(q * 16 + 2 * i) * 72 + j] = (bf16_t)(w[i] & 0xffffu);
    dst[(q * 16 + 2 * i + 1) * 72 + j] = (bf16_t)(w[i] >> 16);
  }
}
__device__ __forceinline__ void stage_rows_f32(bf16_t* dst, const float* src) {
  const int t = tid_() & 255, r = t >> 2, q = t & 3;
  const f32x4* s = (const f32x4*)(src + r * 64 + q * 16);
  f32x4 a = s[0], b = s[1], c = s[2], d = s[3];
  u32x4 o0, o1;
  o0.x = pack2(a[0], a[1]); o0.y = pack2(a[2], a[3]); o0.z = pack2(b[0], b[1]); o0.w = pack2(b[2], b[3]);
  o1.x = pack2(c[0], c[1]); o1.y = pack2(c[2], c[3]); o1.z = pack2(d[0], d[1]); o1.w = pack2(d[2], d[3]);
  u32x4* dd = (u32x4*)(dst + r * 72 + q * 16);
  dd[0] = o0; dd[1] = o1;
}

__device__ __forceinline__ void tile_load(bf16_t* s, const bf16_t* g, int ld, int lane) {
  wave_lds_fence();
#pragma unroll
  for (int i = 0; i < 4; ++i) {
    const int row = (lane >> 3) + 8 * i, ch = lane & 7;
    *(u32x4*)(s + row * 72 + ch * 8) = *(const u32x4*)(g + (size_t)row * ld + ch * 8);
  }
  wave_lds_fence();
}
__device__ __forceinline__ void tile_store(bf16_t* g, int ld, const bf16_t* s, int lane) {
  wave_lds_fence();
#pragma unroll
  for (int i = 0; i < 4; ++i) {
    const int row = (lane >> 3) + 8 * i, ch = lane & 7;
    *(u32x4*)(g + (size_t)row * ld + ch * 8) = *(const u32x4*)(s + row * 72 + ch * 8);
  }
  wave_lds_fence();
}
__device__ __forceinline__ void transpose_item(const float* W, int K, int N, bf16_t* Wt, int item, float* scr) {
  const int nblk = N / 64, kb = item / nblk, nb = item % nblk, k0 = kb * 64, n0 = nb * 64, t = tid_() & 255;
  __syncthreads();
#pragma unroll
  for (int i = 0; i < 4; ++i) {
    const int kk = (t >> 4) + 16 * i, c4 = (t & 15) * 4;
    const f32x4 v = *(const f32x4*)(W + (size_t)(k0 + kk) * N + n0 + c4);
    scr[kk * 65 + c4 + 0] = v[0]; scr[kk * 65 + c4 + 1] = v[1]; scr[kk * 65 + c4 + 2] = v[2]; scr[kk * 65 + c4 + 3] = v[3];
  }
  __syncthreads();
  const int n = t >> 2, q = t & 3;
  unsigned pk[8];
#pragma unroll
  for (int i = 0; i < 8; ++i) pk[i] = pack2(scr[(q * 16 + 2 * i) * 65 + n], scr[(q * 16 + 2 * i + 1) * 65 + n]);
  u32x4* dst = (u32x4*)(Wt + (size_t)(n0 + n) * K + k0 + q * 16);
  u32x4 o0, o1; o0.x = pk[0]; o0.y = pk[1]; o0.z = pk[2]; o0.w = pk[3]; o1.x = pk[4]; o1.y = pk[5]; o1.z = pk[6]; o1.w = pk[7];
  dst[0] = o0; dst[1] = o1;
}

__device__ __forceinline__ void mod_item(const Params& p, int item, float* lds) {
  const int l = item / 96, jb = item % 96, t = tid_() & 255, lane = t & 63, wave = __builtin_amdgcn_readfirstlane(t >> 6);
  float* sc = lds;
  float* red = lds + 18 * 256;
  const float* W = p.w_ada + (size_t)l * D * 6 * D + jb * 64 + lane;
  float acc[NB];
#pragma unroll
  for (int b = 0; b < NB; ++b) acc[b] = 0.f;
  for (int kq = 0; kq < 4; ++kq) {
    __syncthreads();
#pragma unroll
    for (int b = 0; b < NB; ++b) {
      const float c = (b < 2) ? p.cp[b * D + kq * 256 + t] : p.cs[(b - 2) * D + kq * 256 + t];
      sc[b * 256 + t] = silu_f(c);
    }
    __syncthreads();
#pragma unroll 8
    for (int kk = 0; kk < 64; ++kk) {
      const int kl = wave * 64 + kk;
      const float w = W[(size_t)(kq * 256 + kl) * (6 * D)];
#pragma unroll
      for (int b = 0; b < NB; ++b) acc[b] += sc[b * 256 + kl] * w;
    }
  }
#pragma unroll
  for (int b = 0; b < NB; ++b) red[(wave * NB + b) * 64 + lane] = acc[b];
  __syncthreads();
  float* mod = (float*)(p.ws + OFF_MOD);
  for (int idx = t; idx < NB * 64; idx += 256) {
    const int b = idx >> 6, jj = idx & 63;
    const float s = red[(0 * NB + b) * 64 + jj] + red[(1 * NB + b) * 64 + jj] + red[(2 * NB + b) * 64 + jj] + red[(3 * NB + b) * 64 + jj];
    mod[(size_t)(l * NB + b) * 6 * D + jb * 64 + jj] = s + p.b_ada[l * 6 * D + jb * 64 + jj];
  }
}

__device__ __forceinline__ void phase_setup(const Params& p, unsigned char* lds) {
  constexpr int I_MOD = 192, I_TL = 672 + 256 + 1408 + 704, I_T = I_TL * DEPTH, I_SGU = 64, I_RR = 2, I_RA = 0;
  constexpr int NIT = I_MOD + I_T + I_SGU + I_RR + I_RA;
  const int t = tid_() & 255, half = __builtin_amdgcn_readfirstlane(tid_() >> 8);
  lds += half * LDS_BYTES;
  for (int it = blockIdx.x * 2 + half; it < NIT; it += gridDim.x * 2) {
    int r = it;
    if (r < I_MOD) {
      mod_item(p, r, (float*)lds);
      asm volatile("s_waitcnt vmcnt(0)" ::: "memory");
      __syncthreads();
      if (t == 0) {
        __builtin_amdgcn_fence(__ATOMIC_RELEASE, "agent");
        asm volatile("s_waitcnt vmcnt(0)" ::: "memory");
        (void)__hip_atomic_fetch_add((unsigned*)(p.ws + OFF_BAR) + 64, 1u, __ATOMIC_RELAXED, __HIP_MEMORY_SCOPE_AGENT);
      }
      continue;
    }
    r -= I_MOD;
    if (r < I_T) {
      const int l = r / I_TL; r %= I_TL;
      unsigned char* wl = p.ws + SZ_WLAYER * l;
      if (r < 672) { transpose_item(p.w_in + (size_t)l * D * IN_DIM, D, IN_DIM, (bf16_t*)(wl + OFF_WIN), r, (float*)lds); continue; }
      r -= 672;
      if (r < 256) { transpose_item(p.w_out + (size_t)l * D * D, D, D, (bf16_t*)(wl + OFF_WOUT), r, (float*)lds); continue; }
      r -= 256;
      if (r < 1408) { transpose_item(p.w_up + (size_t)l * D * 2 * DFF, D, 2 * DFF, (bf16_t*)(wl + OFF_WUP), r, (float*)lds); continue; }
      r -= 1408;
      transpose_item(p.w_down + (size_t)l * DFF * D, DFF, D, (bf16_t*)(wl + OFF_WDOWN), r, (float*)lds);
      continue;
    }
    r -= I_T;
    if (r < I_SGU) {
      const int l = r / 32, rr = r % 32;
      const float* src = p.sgu_w + (size_t)l * 65536 + rr * 2048 + t * 8;
      bf16_t* dst = (bf16_t*)(p.ws + SZ_WLAYER * l + OFF_SGUW) + rr * 2048 + t * 8;
      const f32x4 a = *(const f32x4*)src, b = *(const f32x4*)(src + 4);
      u32x4 o; o.x = pack2(a[0], a[1]); o.y = pack2(a[2], a[3]); o.z = pack2(b[0], b[1]); o.w = pack2(b[2], b[3]);
      *(u32x4*)dst = o;
      continue;
    }
    r -= I_SGU;
    {
      ((u32x4*)(p.ws + OFF_ZERO))[r * 256 + t] = u32x4{0u, 0u, 0u, 0u};
    }
  }
}

constexpr int NR = 2;
__device__ __forceinline__ void norm_load(const Params& p, int l, int kind, int t0, int lane, f32x4 (&xv)[NR][4], u32x2 (&xu)[NR][4], u32x2 (&yu)[NR][4]) {
  const bool x_f32 = (l == 0) && (kind != 2);
  const bf16_t* xb = kind == 2 ? (const bf16_t*)(p.ws + OFF_RC) : (const bf16_t*)p.out;
  const bf16_t* ybuf = (const bf16_t*)(p.ws + (kind == 2 ? OFF_RA : OFF_RC));
#pragma unroll
  for (int r = 0; r < NR; ++r) {
    const int t = t0 + r;
    if (x_f32) {
      const float* xrow = t < TP ? p.xp + (size_t)t * D : p.xs + (size_t)(t - TP) * D;
#pragma unroll
      for (int j = 0; j < 4; ++j) xv[r][j] = *(const f32x4*)(xrow + (lane + 64 * j) * 4);
    } else {
#pragma unroll
      for (int j = 0; j < 4; ++j) xu[r][j] = *(const u32x2*)(xb + (size_t)t * D + (lane + 64 * j) * 4);
    }
    if (kind != 0) {
#pragma unroll
      for (int j = 0; j < 4; ++j) yu[r][j] = *(const u32x2*)(ybuf + (size_t)t * D + (lane + 64 * j) * 4);
    }
  }
}
__device__ __forceinline__ void norm_rows(const Params& p, int l, int kind, int t0, int lane, f32x4 (&xv)[NR][4], u32x2 (&xu)[NR][4], u32x2 (&yu)[NR][4]) {
  constexpr int R = NR;
  const float* modb = (const float*)(p.ws + OFF_MOD);
  bf16_t* hbuf = (bf16_t*)(p.ws + OFF_RA);
  const int b = batch_of(t0);
  const float* mod = modb + (size_t)(l * NB + b) * 6 * D;
  int hl = l;
  int sh_off = 0, sc_off = D;
  const float* gpre = p.g_pre_mix;
  if (!((l == 0) && (kind != 2))) {
#pragma unroll
    for (int r = 0; r < R; ++r)
#pragma unroll
      for (int j = 0; j < 4; ++j) { xv[r][j][0] = bflo(xu[r][j].x); xv[r][j][1] = bfhi(xu[r][j].x); xv[r][j][2] = bflo(xu[r][j].y); xv[r][j][3] = bfhi(xu[r][j].y); }
  }
  if (kind != 0) {
    float rs[R];
#pragma unroll
    for (int r = 0; r < R; ++r) {
      float ss = 0.f;
#pragma unroll
      for (int j = 0; j < 4; ++j) {
        const float a0 = bflo(yu[r][j].x), a1 = bfhi(yu[r][j].x), a2 = bflo(yu[r][j].y), a3 = bfhi(yu[r][j].y);
        ss += a0 * a0 + a1 * a1 + a2 * a2 + a3 * a3;
      }
      rs[r] = ss;
    }
#pragma unroll
    for (int o = 1; o < 64; o <<= 1)
#pragma unroll
      for (int r = 0; r < R; ++r) rs[r] += __shfl_xor(rs[r], o);
#pragma unroll
    for (int r = 0; r < R; ++r) rs[r] = rsqrtf(rs[r] * (1.f / D) + EPS);
    const float* gpost = (kind == 1 ? p.g_post_mix : p.g_post_ffn) + l * D;
    const float* gt = mod + (kind == 1 ? 2 * D : 5 * D);
    const bool last = (kind == 2) && (l + 1 >= DEPTH);
    bf16_t* xbo = kind == 1 ? (bf16_t*)(p.ws + OFF_RC) : (bf16_t*)p.out;
#pragma unroll
    for (int j = 0; j < 4; ++j) {
      const int c = (lane + 64 * j) * 4;
      const f32x4 g = *(const f32x4*)(gpost + c), gg = *(const f32x4*)(gt + c);
#pragma unroll
      for (int r = 0; r < R; ++r) {
        const float y0 = bflo(yu[r][j].x), y1 = bfhi(yu[r][j].x), y2 = bflo(yu[r][j].y), y3 = bfhi(yu[r][j].y);
        xv[r][j][0] += gg[0] * (y0 * rs[r] * g[0]); xv[r][j][1] += gg[1] * (y1 * rs[r] * g[1]);
        xv[r][j][2] += gg[2] * (y2 * rs[r] * g[2]); xv[r][j][3] += gg[3] * (y3 * rs[r] * g[3]);
        if (last) *(f32x4*)(p.out + (size_t)(t0 + r) * D + c) = xv[r][j];
        else { u32x2 o2; o2.x = pack2(xv[r][j][0], xv[r][j][1]); o2.y = pack2(xv[r][j][2], xv[r][j][3]); *(u32x2*)(xbo + (size_t)(t0 + r) * D + c) = o2; }
      }
    }
    if (kind == 1) { sh_off = 3 * D; sc_off = 4 * D; gpre = p.g_pre_ffn; }
    else { hl = l + 1; if (hl >= DEPTH) return; mod = modb + (size_t)(hl * NB + b) * 6 * D; }
  }
  float rx[R];
#pragma unroll
  for (int r = 0; r < R; ++r) {
    float ss = 0.f;
#pragma unroll
    for (int j = 0; j < 4; ++j) ss += xv[r][j][0] * xv[r][j][0] + xv[r][j][1] * xv[r][j][1] + xv[r][j][2] * xv[r][j][2] + xv[r][j][3] * xv[r][j][3];
    rx[r] = ss;
  }
#pragma unroll
  for (int o = 1; o < 64; o <<= 1)
#pragma unroll
    for (int r = 0; r < R; ++r) rx[r] += __shfl_xor(rx[r], o);
#pragma unroll
  for (int r = 0; r < R; ++r) rx[r] = rsqrtf(rx[r] * (1.f / D) + EPS);
#pragma unroll
  for (int j = 0; j < 4; ++j) {
    const int c = (lane + 64 * j) * 4;
    const f32x4 g = *(const f32x4*)(gpre + hl * D + c), sc = *(const f32x4*)(mod + sc_off + c), sh = *(const f32x4*)(mod + sh_off + c);
#pragma unroll
    for (int r = 0; r < R; ++r) {
      float h[4];
#pragma unroll
      for (int e = 0; e < 4; ++e) h[e] = xv[r][j][e] * rx[r] * g[e] * (1.f + sc[e]) + sh[e];
      u32x2 o2; o2.x = pack2(h[0], h[1]); o2.y = pack2(h[2], h[3]);
      *(u32x2*)(hbuf + (size_t)(t0 + r) * D + c) = o2;
    }
  }
}
__device__ __forceinline__ void phase_norm(const Params& p, int l, int kind) {
  const int lane = tid_() & 63, wave = __builtin_amdgcn_readfirstlane(tid_() >> 6);
  const int gw = blockIdx.x * 8 + wave, NW = gridDim.x * 8;
  if (kind == 0) {
    if (threadIdx.x == 0) {
      unsigned* flag = (unsigned*)(p.ws + OFF_BAR) + 64;
      unsigned sp = 0;
      while (__hip_atomic_load(flag, __ATOMIC_RELAXED, __HIP_MEMORY_SCOPE_AGENT) < 192u && ++sp < (1u << 22)) __builtin_amdgcn_s_sleep(1);
      __builtin_amdgcn_fence(__ATOMIC_ACQUIRE, "agent");
      asm volatile("s_waitcnt vmcnt(0)" ::: "memory");
    }
    __syncthreads();
  }
  constexpr int NG = T / NR;
  f32x4 xa[NR][4], xb[NR][4]; u32x2 ua[NR][4], ub[NR][4], ya[NR][4], yb[NR][4];
  if (gw < NG) norm_load(p, l, kind, gw * NR, lane, xa, ua, ya);
  for (int g = gw; g < NG; g += 2 * NW) {
    if (g + NW < NG) norm_load(p, l, kind, (g + NW) * NR, lane, xb, ub, yb);
    norm_rows(p, l, kind, g * NR, lane, xa, ua, ya);
    if (g + 2 * NW < NG) norm_load(p, l, kind, (g + 2 * NW) * NR, lane, xa, ua, ya);
    if (g + NW < NG) norm_rows(p, l, kind, (g + NW) * NR, lane, xb, ub, yb);
  }
}

typedef __attribute__((ext_vector_type(4))) float f32x4v;
extern __shared__ __attribute__((aligned(16))) unsigned char dyn_lds[];
namespace g8 {
constexpr int BK = 64, HALF = 128, HT = HALF * BK;
__device__ __forceinline__ int lds_byte(int r, int c) {
  const int st = (r >> 4) * 2 + (c >> 5), rr = r & 15, cc = c & 31, ob = rr * 64 + cc * 2;
  return st * 1024 + (ob ^ (((ob >> 9) & 1) << 5));
}
__device__ __forceinline__ void stage_rc(int b, int& R, int& C) {
  const int st = b / 1024, sb = b % 1024, swz = sb ^ (((sb >> 9) & 1) << 5);
  R = (st >> 1) * 16 + swz / 64; C = (st & 1) * 32 + (swz % 64) / 2;
}
}

template <int KIND>
__device__ __forceinline__ void epi_block(const f32x4v (&a)[4][2], bf16_t* sW, int pos0, float frq, float scl, int u, int fr, int fq) {
#pragma unroll
  for (int m = 0; m < 4; ++m) {
#pragma unroll
    for (int j = 0; j < 4; ++j) {
      float v0 = a[m][0][j], v1 = a[m][1][j];
      if (KIND == 1) { v0 = gelu_t(v0); v1 = gelu_t(v1); }
      if (KIND == 3) { v0 = silu_f(v0); v1 = silu_f(v1); }
      if (KIND == 2) {
        float xr = (float)(pos0 + m * 16 + j) * frq; xr -= floorf(xr);
        const float cx = __builtin_amdgcn_cosf(xr), sx = __builtin_amdgcn_sinf(xr);
        const float o0 = v0 * cx - v1 * sx, o1 = v0 * sx + v1 * cx;
        v0 = o0 * scl; v1 = o1 * scl;
      }
      if (KIND == 4) {
        const float partner = __shfl_xor(v0, 8);
        float xr = (float)(pos0 + m * 16 + j) * frq; xr -= floorf(xr);
        const float cx = __builtin_amdgcn_cosf(xr), sx = __builtin_amdgcn_sinf(xr);
        float o = v0;
        if (u == 0) { if (fr < 8) o = v0 * cx - partner * sx; else o = partner * sx + v0 * cx; }
        v0 = o * scl; v1 = v1 * scl;
      }
      const int rl = m * 16 + fq * 4 + j;
      sW[rl * 40 + fr] = f2bf(v0);
      sW[rl * 40 + 16 + fr] = f2bf(v1);
    }
  }
}

__device__ __forceinline__ void g3_window(int id, int& lo, int& hi, int& ti) {
  if (id < 132) { const int sq = id / 66; ti = id - sq * 66; lo = sq * 8192; hi = lo + 8192; }
  else { const int i2 = id - 132, sq = i2 / 17; ti = i2 - sq * 17; lo = TP + sq * 2048; hi = lo + 2048; }
}
template <int MODE>
__device__ __forceinline__ void g8_setup(const Params& p, int pm, int pn, const bf16_t* A, const bf16_t* Bt, int K, int tid,
                                         unsigned (&uA)[2][2], unsigned (&uB)[2], const char* (&Ab)[2], const char* (&Bb)[2],
                                         int& seq_lo, int& seq_hi, int& pj) {
  using namespace g8;
  seq_lo = 0; seq_hi = T; pj = 0;
  const char* zrow = (const char*)(p.ws + OFF_ZERO);
  Ab[0] = (const char*)A; Ab[1] = (const char*)A + (MODE == 3 ? 0 : (size_t)128 * K * 2);
  Bb[0] = (const char*)Bt; Bb[1] = (const char*)Bt + (size_t)(MODE == 3 ? DFF : 128) * K * 2;
#pragma unroll
  for (int i = 0; i < 2; ++i) {
    int R, C; stage_rc(tid * 16 + i * 8192, R, C);
#pragma unroll
    for (int h = 0; h < 2; ++h) {
      if (MODE == 3) {
        int wlo, whi, wti; g3_window(2 * pm + h, wlo, whi, wti);
        const int ar = wlo + 126 * wti - 1 + R;
        const bool ok = ar >= wlo && ar < whi;
        uA[h][i] = ok ? (unsigned)(ar * K + C) * 2u : (unsigned)(zrow - (const char*)A) + (unsigned)C * 2u;
      } else uA[h][i] = (unsigned)((pm * 256 + R) * K + C) * 2u;
    }
    int br;
    if (MODE == 1) {
      const int wcp = R >> 5, n = (R >> 4) & 1, f = R & 15;
      br = pn * 256 + (wcp >> 1) * 64 + (wcp & 1) * 16 + n * 32 + f;
    } else if (MODE == 3) br = pn * 128 + R;
    else br = pn * 256 + R;
    uB[i] = (unsigned)(br * K + C) * 2u;
  }
}

template <int MODE, bool HALFN = false>
__device__ __forceinline__ void gemm256(const Params& p, int l, int pm, int pn, const bf16_t* A, const bf16_t* Bt, int K,
                                        bool first, bool has_next, int pm_n, int pn_n, size_t out_off) {
  using namespace g8;
  bf16_t* shm = (bf16_t*)dyn_lds;
  const int tid = tid_(), lane = tid & 63, wid = __builtin_amdgcn_readfirstlane(tid >> 6), wr = wid >> 2, wc = wid & 3, fr = lane & 15, fq = lane >> 4;
  int seq_lo, seq_hi, pj;
  unsigned uA[2][2], uB[2];
  const char* Ab[2]; const char* Bb[2];
  g8_setup<MODE>(p, pm, pn, A, Bt, K, tid, uA, uB, Ab, Bb, seq_lo, seq_hi, pj);
#define SA(b, h) (shm + ((b) * 2 + (h)) * HT)
#define SB(b, h) (shm + (4 + (b) * 2 + (h)) * HT)
#define STAGE(P, BASE, OFFS, kt)                                                                                        \
  do {                                                                                                                  \
    const unsigned _ko = (unsigned)((kt) * (BK * 2));           \
    _Pragma("unroll") for (int _i = 0; _i < 2; ++_i) {                                                                  \
      __builtin_amdgcn_global_load_lds((const unsigned*)((BASE) + (size_t)((OFFS)[_i] + _ko)),                          \
                                       (unsigned*)((char*)(P) + tid * 16 + _i * 8192), 16, 0, 0);                       \
    }                                                                                                                   \
  } while (0)
#define LDA(dst, b, h)                                                                                                  \
  _Pragma("unroll") for (int m = 0; m < 4; ++m) _Pragma("unroll") for (int k = 0; k < 2; ++k)                           \
      dst[m][k] = *reinterpret_cast<const bf16x8*>((char*)SA(b, h) + lds_byte(wr * 64 + m * 16 + fr, k * 32 + fq * 8))
#define LDB(dst, b, h)                                                                                                  \
  _Pragma("unroll") for (int n = 0; n < 2; ++n) _Pragma("unroll") for (int k = 0; k < 2; ++k)                           \
      dst[n][k] = *reinterpret_cast<const bf16x8*>((char*)SB(b, h) + lds_byte(wc * 32 + n * 16 + fr, k * 32 + fq * 8))
#define MMA(ai, bj, At_, Bt_)                                                                                           \
  if (!(HALFN && (bj) == 1)) do {       \
    __builtin_amdgcn_s_setprio(1);                                                                                      \
    _Pragma("unroll") for (int m = 0; m < 4; ++m) _Pragma("unroll") for (int n = 0; n < 2; ++n)                         \
        _Pragma("unroll") for (int k = 0; k < 2; ++k) acc[ai][bj][m][n] =                                               \
            __builtin_amdgcn_mfma_f32_16x16x32_bf16(At_[m][k], Bt_[n][k], acc[ai][bj][m][n], 0, 0, 0);                 \
    __builtin_amdgcn_s_setprio(0);                                                                                      \
  } while (0)
#define WAIT_V(n) asm volatile("s_waitcnt vmcnt(" #n ")" ::: "memory")
#define WAIT_L(n) asm volatile("s_waitcnt lgkmcnt(" #n ")" ::: "memory")
#define BAR __builtin_amdgcn_s_barrier()
#define SCHED __builtin_amdgcn_sched_barrier(0)
  f32x4v acc[2][2][4][2];
#pragma unroll
  for (int a = 0; a < 2; ++a)
#pragma unroll
    for (int b = 0; b < 2; ++b)
#pragma unroll
      for (int m = 0; m < 4; ++m)
#pragma unroll
        for (int n = 0; n < 2; ++n) acc[a][b][m][n] = f32x4v{0.f, 0.f, 0.f, 0.f};
  bf16x8 At[4][2], B0[2][2], B1[2][2];
  const int nt = K / BK;
  if (first) {
    WAIT_V(0);
    BAR;
    STAGE(SB(0, 0), Bb[0], uB, 0); STAGE(SA(0, 0), Ab[0], uA[0], 0);
    STAGE(SB(0, 1), Bb[1], uB, 0); STAGE(SA(0, 1), Ab[1], uA[MODE == 3 ? 1 : 0], 0);
  }
  if (wr == 1) BAR;
  WAIT_V(4); BAR;
  STAGE(SB(1, 0), Bb[0], uB, 1); STAGE(SA(1, 0), Ab[0], uA[0], 1); STAGE(SB(1, 1), Bb[1], uB, 1);
  WAIT_V(6); BAR;
  for (int t = 0; t < nt - 2; t += 2) {
    LDB(B0, 0, 0); SCHED; LDA(At, 0, 0); STAGE(SA(1, 1), Ab[1], uA[MODE == 3 ? 1 : 0], t + 1);
    WAIT_L(8); BAR; WAIT_L(0); MMA(0, 0, At, B0); BAR; SCHED;
    LDB(B1, 0, 1); STAGE(SB(0, 0), Bb[0], uB, t + 2);
    BAR; WAIT_L(0); MMA(0, 1, At, B1); BAR;
    LDA(At, 0, 1); STAGE(SA(0, 0), Ab[0], uA[0], t + 2);
    BAR; WAIT_L(0); MMA(1, 0, At, B0); BAR; SCHED;
    STAGE(SB(0, 1), Bb[1], uB, t + 2);
    WAIT_V(6); BAR; MMA(1, 1, At, B1); BAR;
    LDB(B0, 1, 0); SCHED; LDA(At, 1, 0); STAGE(SA(0, 1), Ab[1], uA[MODE == 3 ? 1 : 0], t + 2);
    WAIT_L(8); BAR; WAIT_L(0); MMA(0, 0, At, B0); BAR; SCHED;
    LDB(B1, 1, 1); STAGE(SB(1, 0), Bb[0], uB, t + 3);
    BAR; WAIT_L(0); MMA(0, 1, At, B1); BAR;
    LDA(At, 1, 1); STAGE(SA(1, 0), Ab[0], uA[0], t + 3);
    BAR; WAIT_L(0); MMA(1, 0, At, B0); BAR; SCHED;
    STAGE(SB(1, 1), Bb[1], uB, t + 3);
    WAIT_V(6); BAR; MMA(1, 1, At, B1); BAR;
  }
  { LDB(B0, 0, 0); LDA(At, 0, 0); STAGE(SA(1, 1), Ab[1], uA[MODE == 3 ? 1 : 0], nt - 1);
    BAR; WAIT_L(0); MMA(0, 0, At, B0); BAR;
    LDB(B1, 0, 1); BAR; WAIT_L(0); MMA(0, 1, At, B1); BAR;
    LDA(At, 0, 1); WAIT_V(4); BAR; WAIT_L(0); MMA(1, 0, At, B0); MMA(1, 1, At, B1); BAR; }
  { LDB(B0, 1, 0); LDA(At, 1, 0); WAIT_V(2); BAR; WAIT_L(0); MMA(0, 0, At, B0); BAR;
    LDB(B1, 1, 1); WAIT_V(0); BAR; WAIT_L(0); MMA(0, 1, At, B1); BAR;
    LDA(At, 1, 1); BAR; WAIT_L(0); MMA(1, 0, At, B0); MMA(1, 1, At, B1); BAR; }
  if (wr == 0) BAR;
  const int cp = tid & 63, rg = tid >> 6, c0 = pn * 128 + 2 * cp;
  float kg[2][4], kv[2][4];
  if (MODE == 3) {
    const float* cw = p.conv_w + (size_t)l * 3 * 2 * DFF;
    const float* cb = p.conv_b + (size_t)l * 2 * DFF;
#pragma unroll
    for (int c = 0; c < 2; ++c) {
      kg[c][0] = cw[c0 + c]; kg[c][1] = cw[2 * DFF + c0 + c]; kg[c][2] = cw[4 * DFF + c0 + c]; kg[c][3] = cb[c0 + c];
      kv[c][0] = cw[DFF + c0 + c]; kv[c][1] = cw[3 * DFF + c0 + c]; kv[c][2] = cw[5 * DFF + c0 + c]; kv[c][3] = cb[DFF + c0 + c];
    }
  }
  if (has_next) {
    int s_lo, s_hi, pj2; unsigned nA[2][2], nB[2]; const char* nAb[2]; const char* nBb[2];
    g8_setup<MODE>(p, pm_n, pn_n, A, Bt, K, tid, nA, nB, nAb, nBb, s_lo, s_hi, pj2);
    STAGE(SB(0, 0), nBb[0], nB, 0); STAGE(SA(0, 0), nAb[0], nA[0], 0);
    STAGE(SB(0, 1), nBb[1], nB, 0); STAGE(SA(0, 1), nAb[1], nA[MODE == 3 ? 1 : 0], 0);
  }
#undef SA
#undef SB
#undef STAGE
#undef LDA
#undef LDB
#undef MMA
  if (MODE == 1 || MODE == 2) {
    bf16_t* sW = (bf16_t*)((unsigned char*)shm + (wid < 4 ? 32768 : 98304) + (wid & 3) * 5120);
    bf16_t* outp = (bf16_t*)(p.ws + (MODE == 1 ? OFF_RB : out_off));
    const int ldo = MODE == 1 ? IN_DIM : D;
#pragma unroll
    for (int ai = 0; ai < 2; ++ai) {
      const int row0 = pm * 256 + ai * 128 + wr * 64;
#pragma unroll
      for (int bj = 0; bj < (HALFN ? 1 : 2); ++bj) {
        const int cgi = pn * 4 + bj * 2 + (wc >> 1), u = wc & 1;
        int kind = 0; float scl = 1.f;
        if (MODE == 1) {
          kind = cgi < 8 ? 1 : cgi < 20 ? 2 : cgi < 26 ? 0 : cgi < 32 ? 3 : cgi < 40 ? 4 : 0;
          scl = (cgi >= 14 && cgi < 20) || (cgi >= 32 && cgi < 38) ? 0.125f : 1.f;
        }
        float frq = 0.f;
        if (MODE == 1) {
          if (kind == 2) frq = expf(-9.210340371976184f * (float)(u * 16 + fr) * (2.0f / 64.f)) * 0.15915494309189535f;
          if (kind == 4) frq = expf(-13.122363377404328f * (float)(fr & 7) * (2.0f / 16.f)) * 0.15915494309189535f;
        }
        const int pos0 = pos_of(row0) + fq * 4;
        if (MODE == 1 && kind == 1) epi_block<1>(acc[ai][bj], sW, pos0, frq, scl, u, fr, fq);
        else if (MODE == 1 && kind == 2) epi_block<2>(acc[ai][bj], sW, pos0, frq, scl, u, fr, fq);
        else if (MODE == 1 && kind == 3) epi_block<3>(acc[ai][bj], sW, pos0, frq, scl, u, fr, fq);
        else if (MODE == 1 && kind == 4) epi_block<4>(acc[ai][bj], sW, pos0, frq, scl, u, fr, fq);
        else epi_block<0>(acc[ai][bj], sW, pos0, frq, scl, u, fr, fq);
        wave_lds_fence();
#pragma unroll
        for (int i = 0; i < 4; ++i) {
          const int idx = lane + 64 * i, row = idx >> 2, q = idx & 3;
          int col;
          if (MODE == 1) col = pn * 256 + bj * 128 + (wc >> 1) * 64 + (wc & 1) * 16 + (q >> 1) * 32 + (q & 1) * 8;
          else col = pn * 256 + bj * 128 + wc * 32 + q * 8;
          if (MODE != 1 || col < IN_DIM)
            *(u32x4*)(outp + (size_t)(row0 + row) * ldo + col) = *(const u32x4*)(sW + row * 40 + q * 8);
        }
        wave_lds_fence();
      }
    }
  } else {
    unsigned char* sUg = (unsigned char*)shm + 32768;
    unsigned char* sUv = (unsigned char*)shm + 98304;
    bf16_t* act = (bf16_t*)(p.ws + OFF_RB);
#pragma unroll
    for (int ai = 0; ai < 2; ++ai) {
      if (ai) { WAIT_L(0); BAR; }
#pragma unroll
      for (int bj = 0; bj < 2; ++bj)
#pragma unroll
        for (int m = 0; m < 4; ++m)
#pragma unroll
          for (int n = 0; n < 2; ++n) {
            const int col = wc * 32 + n * 16 + fr, un = wr * 8 + m * 2 + (fq >> 1);
            u32x2 w2; w2.x = pack2(acc[ai][bj][m][n][0], acc[ai][bj][m][n][1]); w2.y = pack2(acc[ai][bj][m][n][2], acc[ai][bj][m][n][3]);
            *(u32x2*)((bj ? sUv : sUg) + col * 256 + ((un ^ (col & 15)) << 4) + (fq & 1) * 8) = w2;
          }
      WAIT_L(0); BAR;
      float outv[2][16];
#pragma unroll
      for (int c = 0; c < 2; ++c) {
        const int col = 2 * cp + c;
        float g[24], v[24];
#pragma unroll
        for (int uu = 0; uu < 3; ++uu) {
          u32x4 qg = u32x4{0u, 0u, 0u, 0u}, qv = qg;
          if (uu < 2 || rg < 7) {
            const int un = rg * 2 + uu;
            qg = *(const u32x4*)(sUg + col * 256 + ((un ^ (col & 15)) << 4));
            qv = *(const u32x4*)(sUv + col * 256 + ((un ^ (col & 15)) << 4));
          }
          g[uu * 8 + 0] = bflo(qg.x); g[uu * 8 + 1] = bfhi(qg.x); g[uu * 8 + 2] = bflo(qg.y); g[uu * 8 + 3] = bfhi(qg.y);
          g[uu * 8 + 4] = bflo(qg.z); g[uu * 8 + 5] = bfhi(qg.z); g[uu * 8 + 6] = bflo(qg.w); g[uu * 8 + 7] = bfhi(qg.w);
          v[uu * 8 + 0] = bflo(qv.x); v[uu * 8 + 1] = bfhi(qv.x); v[uu * 8 + 2] = bflo(qv.y); v[uu * 8 + 3] = bfhi(qv.y);
          v[uu * 8 + 4] = bflo(qv.z); v[uu * 8 + 5] = bfhi(qv.z); v[uu * 8 + 6] = bflo(qv.w); v[uu * 8 + 7] = bfhi(qv.w);
        }
#pragma unroll
        for (int o = 0; o < 16; ++o) {
          const float cgv = kg[c][3] + kg[c][0] * g[o] + kg[c][1] * g[o + 1] + kg[c][2] * g[o + 2];
          const float cvv = kv[c][3] + kv[c][0] * v[o] + kv[c][1] * v[o + 1] + kv[c][2] * v[o + 2];
          outv[c][o] = gelu_t(cgv) * cvv;
        }
      }
      int wlo, whi, wti; g3_window(2 * pm + ai, wlo, whi, wti);
      const int tokb = wlo + 126 * wti + rg * 16;
#pragma unroll
      for (int o = 0; o < 16; ++o) {
        const int tok = tokb + o;
        if (rg * 16 + o < 126 && tok < whi) *(unsigned*)(act + (size_t)tok * DFF + c0) = pack2(outv[0][o], outv[1][o]);
      }
    }
  }
#undef WAIT_V
#undef WAIT_L
#undef BAR
#undef SCHED
}

__device__ __forceinline__ void r1_item(const Params& p, int l, int chunk, int h, unsigned char* lds) {
  bf16_t* sV = (bf16_t*)lds;
  bf16_t* sKf = sV + 64 * 72;
  bf16_t* sKb = sKf + 64 * 72;
  const int t = tid_() & 255, lane = t & 63, wave = __builtin_amdgcn_readfirstlane(t >> 6), dir = wave >> 1, eh = wave & 1;
  const bf16_t* proj = (const bf16_t*)(p.ws + OFF_RB);
  const float zf = p.dec_f[l * 6 + h], zb = p.dec_b[l * 6 + h];
  const float lgf = -log1pf(expf(-zf)) * 1.4426950408889634f, lgb = -log1pf(expf(-zb)) * 1.4426950408889634f;
  f32x16 acc[2]; acc[0] = zero16(); acc[1] = zero16();
  for (int jb = 0; jb < 2; ++jb) {
    const int tok0 = chunk * 128 + jb * 64;
    const int jg = jb * 64 + (t & 63);
    __syncthreads();
    stage_T_bf16(sV, proj + (size_t)tok0 * IN_DIM + 1280 + h * 64, IN_DIM, 1.f);
    stage_T_bf16(sKf, proj + (size_t)tok0 * IN_DIM + 896 + h * 64, IN_DIM, fexp2((float)(127 - jg) * lgf));
    stage_T_bf16(sKb, proj + (size_t)tok0 * IN_DIM + 896 + h * 64, IN_DIM, fexp2((float)jg * lgb));
    __syncthreads();
    bf16x8 afr[4];
#pragma unroll
    for (int s = 0; s < 4; ++s) afr[s] = *(const bf16x8*)(sV + (eh * 32 + (lane & 31)) * 72 + s * 16 + (lane >> 5) * 8);
    mma_rt(afr, dir ? sKb : sKf, acc, lane);
  }
  float* kvs = (float*)(p.ws + OFF_RC) + ((size_t)(chunk * 6 + h) * 2 + dir) * 4096;
#pragma unroll
  for (int n2 = 0; n2 < 2; ++n2)
#pragma unroll
    for (int reg = 0; reg < 16; ++reg) kvs[(eh * 32 + crow(reg, lane)) * 64 + n2 * 32 + (lane & 31)] = acc[n2][reg];
}

__device__ __forceinline__ void phase_scan(const Params& p, int l) {
  float* kvs = (float*)(p.ws + OFF_RC);
  const int total = NB * 6 * 2 * 4096;
  for (int idx = blockIdx.x * 512 + tid_(); idx < total; idx += gridDim.x * 512) {
    const int elem = idx & 4095, r = idx >> 12, dir = r & 1, hh = (r >> 1) % 6, sq = (r >> 1) / 6;
    const int c0 = sq < 2 ? sq * 64 : 128 + (sq - 2) * 16, n = sq < 2 ? 64 : 16;
    const float z = dir ? p.dec_b[l * 6 + hh] : p.dec_f[l * 6 + hh];
    const float cd = exp2f(-log1pf(expf(-z)) * 1.4426950408889634f * 128.f);
    float state = 0.f;
    for (int i0 = 0; i0 < n; i0 += 16) {
      float v[16];
#pragma unroll
      for (int i = 0; i < 16; ++i) {
        const int ci = dir ? (n - 1 - (i0 + i)) : (i0 + i);
        v[i] = kvs[((size_t)((c0 + ci) * 6 + hh) * 2 + dir) * 4096 + elem];
      }
#pragma unroll
      for (int i = 0; i < 16; ++i) {
        const int ci = dir ? (n - 1 - (i0 + i)) : (i0 + i);
        kvs[((size_t)((c0 + ci) * 6 + hh) * 2 + dir) * 4096 + elem] = state;
        state = state * cd + v[i];
      }
    }
  }
}

__device__ __forceinline__ void mix_sgu(const Params& p, int l, int chunk, int unit, unsigned char* lds) {
  bf16_t* sK = (bf16_t*)lds;
  bf16_t* sV = sK + 64 * 72;
  const int t = tid_() & 255, lane = t & 63, wave = __builtin_amdgcn_readfirstlane(t >> 6), cl = lane & 31, hh = lane >> 5;
  bf16_t* sP = sV + 64 * 72 + wave * 32 * 72;
  const bf16_t* proj = (const bf16_t*)(p.ws + OFF_RB);
  bf16_t* ymix = (bf16_t*)(p.ws + OFF_RA);
  const int tok0 = chunk * 128;
  const int rowA = tok0 + wave * 32 + cl;

    const int g = unit;
    const bf16_t* Ws = (const bf16_t*)(p.ws + SZ_WLAYER * l + OFF_SGUW) + (size_t)g * 128 * 128;
    f32x16 acc[2]; acc[0] = zero16(); acc[1] = zero16();
    for (int jb = 0; jb < 2; ++jb) {
      __syncthreads();
      {
        const int j = t >> 2, q = t & 3;
        const u32x4* s = (const u32x4*)(proj + (size_t)(tok0 + jb * 64 + j) * IN_DIM + 256 + g * 64 + q * 16);
        const u32x4 a = s[0], b = s[1];
        const unsigned w[8] = {a.x, a.y, a.z, a.w, b.x, b.y, b.z, b.w};
        float ss = 0.f;
#pragma unroll
        for (int i = 0; i < 8; ++i) { const float lo = bflo(w[i]), hi = bfhi(w[i]); ss += lo * lo + hi * hi; }
        ss += __shfl_xor(ss, 1); ss += __shfl_xor(ss, 2);
        const float rstd = rsqrtf(ss * (1.f / 64.f) + EPS);
        const float* ng = p.sgu_norm + l * 256 + g * 64 + q * 16;
#pragma unroll
        for (int i = 0; i < 8; ++i) {
          sV[(q * 16 + 2 * i) * 72 + j] = f2bf(bflo(w[i]) * rstd * ng[2 * i]);
          sV[(q * 16 + 2 * i + 1) * 72 + j] = f2bf(bfhi(w[i]) * rstd * ng[2 * i + 1]);
        }
      }
      __syncthreads();
      bf16x8 afr[4];
#pragma unroll
      for (int s = 0; s < 4; ++s) afr[s] = *(const bf16x8*)(Ws + (wave * 32 + cl) * 128 + jb * 64 + s * 16 + hh * 8);
      mma_rt(afr, sV, acc, lane);
    }
    const float* sb = p.sgu_b + l * 512 + g * 128 + wave * 32;
    tile_load(sP, proj + (size_t)(tok0 + wave * 32) * IN_DIM + g * 64, IN_DIM, lane);
#pragma unroll
    for (int reg = 0; reg < 16; ++reg) {
      const int r = crow(reg, lane);
      const float bias = sb[r];
#pragma unroll
      for (int n2 = 0; n2 < 2; ++n2) {
        const float u = bf2f(sP[r * 72 + n2 * 32 + cl]);
        sP[r * 72 + n2 * 32 + cl] = f2bf(u * (acc[n2][reg] + bias));
      }
    }
    tile_store(ymix + (size_t)(tok0 + wave * 32) * D + g * 64, D, sP, lane);
}
__device__ __forceinline__ void mix_ret(const Params& p, int l, int chunk, int unit, unsigned char* lds) {
  bf16_t* sK = (bf16_t*)lds;
  bf16_t* sV = sK + 64 * 72;
  const int t = tid_() & 255, lane = t & 63, wave = __builtin_amdgcn_readfirstlane(t >> 6), cl = lane & 31, hh = lane >> 5;
  bf16_t* sP = sV + 64 * 72 + wave * 32 * 72;
  const bf16_t* proj = (const bf16_t*)(p.ws + OFF_RB);
  bf16_t* ymix = (bf16_t*)(p.ws + OFF_RA);
  const int tok0 = chunk * 128;
  const int rowA = tok0 + wave * 32 + cl;

    const int h = unit - 4;
    const float zf = p.dec_f[l * 6 + h], zb = p.dec_b[l * 6 + h];
    const float lgf = -log1pf(expf(-zf)) * 1.4426950408889634f, lgb = -log1pf(expf(-zb)) * 1.4426950408889634f;
    bf16x8 afr[4];
#pragma unroll
    for (int s = 0; s < 4; ++s) afr[s] = *(const bf16x8*)(proj + (size_t)rowA * IN_DIM + 512 + h * 64 + s * 16 + hh * 8);
    f32x16 O[2]; O[0] = zero16(); O[1] = zero16();
    for (int jb = 0; jb < 2; ++jb) {
      __syncthreads();
      stage_rows_bf16(sK, proj + (size_t)(tok0 + jb * 64) * IN_DIM + 896 + h * 64, IN_DIM);
      stage_T_bf16(sV, proj + (size_t)(tok0 + jb * 64) * IN_DIM + 1280 + h * 64, IN_DIM, 1.f);
      __syncthreads();
      f32x16 X[2]; X[0] = zero16(); X[1] = zero16();
#pragma unroll
      for (int s = 0; s < 4; ++s)
#pragma unroll
        for (int tk = 0; tk < 2; ++tk) {
          const bf16x8 a = *(const bf16x8*)(sK + (tk * 32 + cl) * 72 + s * 16 + hh * 8);
          X[tk] = mfma32(a, afr[s], X[tk]);
        }
      int ibase = wave * 32 + cl - jb * 64 - 4 * hh;
      asm volatile("" : "+v"(ibase));
#pragma unroll
      for (int tk = 0; tk < 2; ++tk)
#pragma unroll
        for (int reg = 0; reg < 16; ++reg) {
          const int dd = ibase - tk * 32 - (reg & 3) - 8 * (reg >> 2);
          const float w = dd >= 0 ? fexp2((float)dd * lgf) : fexp2((float)(-dd) * lgb);
          X[tk][reg] *= w;
        }
#pragma unroll
      for (int tk = 0; tk < 2; ++tk)
#pragma unroll
        for (int s2 = 0; s2 < 2; ++s2) {
          u32x4 pb;
          pb.x = pack2(X[tk][8 * s2 + 0], X[tk][8 * s2 + 1]); pb.y = pack2(X[tk][8 * s2 + 2], X[tk][8 * s2 + 3]);
          pb.z = pack2(X[tk][8 * s2 + 4], X[tk][8 * s2 + 5]); pb.w = pack2(X[tk][8 * s2 + 6], X[tk][8 * s2 + 7]);
          const bf16x8 bfrag = __builtin_bit_cast(bf16x8, pb);
#pragma unroll
          for (int te = 0; te < 2; ++te) {
            const bf16_t* vp = sV + (te * 32 + cl) * 72 + tk * 32 + s2 * 16 + 4 * hh;
            const u32x2 v0 = *(const u32x2*)vp, v1 = *(const u32x2*)(vp + 8);
            u32x4 va; va.x = v0.x; va.y = v0.y; va.z = v1.x; va.w = v1.y;
            O[te] = mfma32(__builtin_bit_cast(bf16x8, va), bfrag, O[te]);
          }
        }
    }
    __syncthreads();
    const float* kvs = (const float*)(p.ws + OFF_RC) + ((size_t)(chunk * 6 + h) * 2) * 4096;
    stage_rows_f32(sK, kvs);
    stage_rows_f32(sV, kvs + 4096);
    __syncthreads();
    f32x16 Cf[2], Cb[2]; Cf[0] = zero16(); Cf[1] = zero16(); Cb[0] = zero16(); Cb[1] = zero16();
#pragma unroll
    for (int s = 0; s < 4; ++s)
#pragma unroll
      for (int te = 0; te < 2; ++te) {
        const bf16x8 af = *(const bf16x8*)(sK + (te * 32 + cl) * 72 + s * 16 + hh * 8);
        const bf16x8 ab = *(const bf16x8*)(sV + (te * 32 + cl) * 72 + s * 16 + hh * 8);
        Cf[te] = mfma32(af, afr[s], Cf[te]);
        Cb[te] = mfma32(ab, afr[s], Cb[te]);
      }
    tile_load(sP, proj + (size_t)(tok0 + wave * 32) * IN_DIM + 1664 + h * 64, IN_DIM, lane);
    {
      const int i = wave * 32 + cl;
      const float wf = fexp2((float)(i + 1) * lgf), wb = fexp2((float)(128 - i) * lgb);
      float ssum = 0.f;
#pragma unroll
      for (int te = 0; te < 2; ++te)
#pragma unroll
        for (int reg = 0; reg < 16; ++reg) { const float y = O[te][reg] + wf * Cf[te][reg] + wb * Cb[te][reg]; O[te][reg] = y; ssum += y; }
      const float mu = (ssum + __shfl_xor(ssum, 32)) * (1.f / 64.f);
      float vsum = 0.f;
#pragma unroll
      for (int te = 0; te < 2; ++te)
#pragma unroll
        for (int reg = 0; reg < 16; ++reg) { const float dlt = O[te][reg] - mu; O[te][reg] = dlt; vsum += dlt * dlt; }
      const float rstd = rsqrtf((vsum + __shfl_xor(vsum, 32)) * (1.f / 64.f) + EPS);
#pragma unroll
      for (int te = 0; te < 2; ++te)
#pragma unroll
        for (int g4 = 0; g4 < 4; ++g4) {
          bf16_t* gp = sP + cl * 72 + te * 32 + 8 * g4 + 4 * hh;
          const u32x2 gq = *(const u32x2*)gp;
          u32x2 o2;
          o2.x = pack2(O[te][4 * g4 + 0] * rstd * bflo(gq.x), O[te][4 * g4 + 1] * rstd * bfhi(gq.x));
          o2.y = pack2(O[te][4 * g4 + 2] * rstd * bflo(gq.y), O[te][4 * g4 + 3] * rstd * bfhi(gq.y));
          *(u32x2*)gp = o2;
        }
    }
    tile_store(ymix + (size_t)(tok0 + wave * 32) * D + 256 + h * 64, D, sP, lane);
}
__device__ __forceinline__ void mix_att(const Params& p, int l, int chunk, int unit, unsigned char* lds) {
  bf16_t* sK = (bf16_t*)lds;
  bf16_t* sV = sK + 64 * 72;
  const int t = tid_() & 255, lane = t & 63, wave = __builtin_amdgcn_readfirstlane(t >> 6), cl = lane & 31, hh = lane >> 5;
  bf16_t* sP = sV + 64 * 72 + wave * 32 * 72;
  const bf16_t* proj = (const bf16_t*)(p.ws + OFF_RB);
  bf16_t* ymix = (bf16_t*)(p.ws + OFF_RA);
  const int tok0 = chunk * 128;
  const int rowA = tok0 + wave * 32 + cl;

    const int hq = unit - 10, kv = hq / 3;
    const int cs = chunk < 128 ? (chunk & 63) : ((chunk - 128) & 15), ncs = chunk < 128 ? 64 : 16;
    const float sink = p.sink[l * 6 + hq];
    bf16x8 afr[4];
#pragma unroll
    for (int s = 0; s < 4; ++s) afr[s] = *(const bf16x8*)(proj + (size_t)rowA * IN_DIM + 2048 + hq * 64 + s * 16 + hh * 8);
    float mrow = sink, lrow = 0.f;
    f32x16 O[2]; O[0] = zero16(); O[1] = zero16();
    u32x4 kr[2], vr[2];
    const bf16_t* kvp = proj + (size_t)(tok0 - 128) * IN_DIM + 2432 + kv * 64;
    if (cs > 0) { ldg_rows(kr, kvp, IN_DIM); ldg_rowsT(vr, kvp + 128, IN_DIM); }
    for (int kb = 0; kb < 6; ++kb) {
      const int kc = cs + (kb >> 1) - 1, kcn = cs + ((kb + 1) >> 1) - 1;
      const bool kvalid = kc >= 0 && kc < ncs;
      __syncthreads();
      if (kvalid) { sts_rows(sK, kr); sts_T_raw(sV, vr); }
      __syncthreads();
      if (kb < 5 && kcn >= 0 && kcn < ncs) {
        ldg_rows(kr, kvp + (size_t)(kb + 1) * 64 * IN_DIM, IN_DIM); ldg_rowsT(vr, kvp + (size_t)(kb + 1) * 64 * IN_DIM + 128, IN_DIM);
      }
      if (!kvalid) continue;
      if ((kb == 0 && wave >= 2) || (kb == 5 && wave < 2)) continue;
      const bool need_mask = (kb < 2) || (kb > 3);
      f32x16 X[2]; X[0] = zero16(); X[1] = zero16();
#pragma unroll
      for (int s = 0; s < 4; ++s)
#pragma unroll
        for (int tk = 0; tk < 2; ++tk) {
          const bf16x8 a = *(const bf16x8*)(sK + (tk * 32 + cl) * 72 + s * 16 + hh * 8);
          X[tk] = mfma32(a, afr[s], X[tk]);
        }
      int dbase = kb * 64 - 128 + 4 * hh - wave * 32 - cl;
      asm volatile("" : "+v"(dbase));
      float mx = -1e30f;
#pragma unroll
      for (int tk = 0; tk < 2; ++tk)
#pragma unroll
        for (int reg = 0; reg < 16; ++reg) {
          const int dd = dbase + tk * 32 + (reg & 3) + 8 * (reg >> 2);
          const float sv = (!need_mask || (dd <= 128 && dd >= -128)) ? X[tk][reg] : -1e30f;
          X[tk][reg] = sv;
          mx = fmaxf(mx, sv);
        }
      mx = fmaxf(mx, __shfl_xor(mx, 32));
      const float mn = fmaxf(mrow, mx);
      const float alpha = __expf(mrow - mn);
      mrow = mn;
      float psum = 0.f;
#pragma unroll
      for (int tk = 0; tk < 2; ++tk)
#pragma unroll
        for (int reg = 0; reg < 16; ++reg) { const float pv = __expf(X[tk][reg] - mn); X[tk][reg] = pv; psum += pv; }
      lrow = lrow * alpha + psum;
#pragma unroll
      for (int reg = 0; reg < 16; ++reg) { O[0][reg] *= alpha; O[1][reg] *= alpha; }
#pragma unroll
      for (int tk = 0; tk < 2; ++tk)
#pragma unroll
        for (int s2 = 0; s2 < 2; ++s2) {
          u32x4 pb;
          pb.x = pack2(X[tk][8 * s2 + 0], X[tk][8 * s2 + 1]); pb.y = pack2(X[tk][8 * s2 + 2], X[tk][8 * s2 + 3]);
          pb.z = pack2(X[tk][8 * s2 + 4], X[tk][8 * s2 + 5]); pb.w = pack2(X[tk][8 * s2 + 6], X[tk][8 * s2 + 7]);
          const bf16x8 bfrag = __builtin_bit_cast(bf16x8, pb);
#pragma unroll
          for (int te = 0; te < 2; ++te) {
            const bf16_t* vp = sV + (te * 32 + cl) * 72 + tk * 32 + s2 * 16 + 4 * hh;
            const u32x2 v0 = *(const u32x2*)vp, v1 = *(const u32x2*)(vp + 8);
            u32x4 va; va.x = v0.x; va.y = v0.y; va.z = v1.x; va.w = v1.y;
            O[te] = mfma32(__builtin_bit_cast(bf16x8, va), bfrag, O[te]);
          }
        }
    }
    {
      const float den = lrow + __shfl_xor(lrow, 32) + __expf(sink - mrow);
      const float inv = 1.f / den;
      wave_lds_fence();
#pragma unroll
      for (int te = 0; te < 2; ++te)
#pragma unroll
        for (int g4 = 0; g4 < 4; ++g4) {
          u32x2 o2;
          o2.x = pack2(O[te][4 * g4 + 0] * inv, O[te][4 * g4 + 1] * inv); o2.y = pack2(O[te][4 * g4 + 2] * inv, O[te][4 * g4 + 3] * inv);
          *(u32x2*)(sP + cl * 72 + te * 32 + 8 * g4 + 4 * hh) = o2;
        }
    }
    tile_store(ymix + (size_t)(tok0 + wave * 32) * D + 640 + hq * 64, D, sP, lane);
}

#ifndef PANEL_H
#define PANEL_H 4
#endif
__device__ __forceinline__ bool xcd_tile(int w, int MT, int NT, int& mt, int& nt) {
  const int x = blockIdx.x & 7;
  const int nq = (MT - x + 7) >> 3;
  const int per_panel = PANEL_H * NT, pi = w / per_panel, idx = w - pi * per_panel;
  const int rows = nq - pi * PANEL_H < PANEL_H ? nq - pi * PANEL_H : PANEL_H;
  if (rows <= 0) return false;
  nt = idx / rows;
  const int mq = idx - nt * rows;
  if (nt >= NT) return false;
  mt = x + 8 * (pi * PANEL_H + mq);
  return mt < MT;
}
__device__ __forceinline__ void run_phase(const Params& p, int ph, unsigned char* lds) {
  const int G = gridDim.x, bid = blockIdx.x;
  const int half = __builtin_amdgcn_readfirstlane(tid_() >> 8), sb = bid * 2 + half, SG = G * 2;
  unsigned char* slds = lds + half * LDS_BYTES;
  if (ph == 0) { phase_setup(p, lds); return; }
  if (ph == 1) { phase_norm(p, 0, 0); return; }
  const int l = (ph - 2) / 9, s = (ph - 2) % 9;
  const unsigned char* wl = p.ws + SZ_WLAYER * l;
  const bf16_t* hbuf = (const bf16_t*)(p.ws + OFF_RA);
  const int xg = G >> 3;
#define GEMM_UNITS(MODE_, WMAX, MT_, NT_, A_, B_, K_, OUT_)                                                             \
  {                                                                                                               \
    int w = bid >> 3, mt, nt; bool first = true;                                                                  \
    while (w < (WMAX) && !xcd_tile(w, MT_, NT_, mt, nt)) w += xg;                                                 \
    while (w < (WMAX)) {                                                                                          \
      int w2 = w + xg, mt2 = 0, nt2 = 0;                                                                          \
      while (w2 < (WMAX) && !xcd_tile(w2, MT_, NT_, mt2, nt2)) w2 += xg;                                          \
      if (MODE_ == 1 && nt == 10) gemm256<MODE_, true>(p, l, mt, nt, A_, B_, K_, first, w2 < (WMAX), mt2, nt2, OUT_);                \
      else gemm256<MODE_>(p, l, mt, nt, A_, B_, K_, first, w2 < (WMAX), mt2, nt2, OUT_);                                   \
      first = false; w = w2; mt = mt2; nt = nt2;                                                                  \
    }                                                                                                             \
  }
  switch (s) {
    case 0: GEMM_UNITS(1, 24 * 11, 192, 11, hbuf, (const bf16_t*)(wl + OFF_WIN), D, OFF_RB) break;
    case 1:
      {
        int it = sb;
        for (; it < NCH * 6; it += SG) r1_item(p, l, it / 6, it % 6, slds);
        for (; it < NCH * 12; it += SG) { const int i2 = it - NCH * 6; mix_att(p, l, i2 / 6, 10 + i2 % 6, slds); }
      }
      break;
    case 2: phase_scan(p, l); break;
    case 3:
      {
        int it = sb;
        for (; it < NCH * 6; it += SG) mix_ret(p, l, it / 6, 4 + it % 6, slds);
        for (; it < NCH * 10; it += SG) { const int i2 = it - NCH * 6; mix_sgu(p, l, i2 >> 2, i2 & 3, slds); }
      }
      break;
    case 4: GEMM_UNITS(2, 24 * 4, 192, 4, hbuf, (const bf16_t*)(wl + OFF_WOUT), D, OFF_RC) break;
    case 5: phase_norm(p, l, 1); break;
    case 6: GEMM_UNITS(3, 28 * 22, 202, 22, hbuf, (const bf16_t*)(wl + OFF_WUP), D, OFF_RB) break;
    case 7: GEMM_UNITS(2, 24 * 4, 192, 4, (const bf16_t*)(p.ws + OFF_RB), (const bf16_t*)(wl + OFF_WDOWN), DFF, OFF_RA) break;
    default: phase_norm(p, l, 2); break;
  }
#undef GEMM_UNITS
}

#define XB_TMO      128
#define XB_XCNT(j)  (256  + 64 * (j))
#define XB_XSUB(j)  (1280 + 64 * (j))
#define XB_XGEN(j)  (2304 + 64 * (j))
#define XB_TOP      3328
#define XB_TOPGEN   3392
#define XB_SPIN_CAP (1u << 18)
#define LAS __attribute__((address_space(3)))
__device__ __forceinline__ unsigned xb_ld(unsigned* p)              { return __hip_atomic_load(p, __ATOMIC_RELAXED, __HIP_MEMORY_SCOPE_AGENT); }
__device__ __forceinline__ unsigned xb_add(unsigned* p, unsigned v) { return __hip_atomic_fetch_add(p, v, __ATOMIC_RELAXED, __HIP_MEMORY_SCOPE_AGENT); }
__device__ __forceinline__ unsigned xb_xcc_id() { return (unsigned)__builtin_amdgcn_s_getreg((3 << 11) | 20) & 0xFu; }
#define XB_SPIN(cond, bar) do { unsigned _sp = 0; while (cond) { __builtin_amdgcn_s_sleep(1); \
    if ((++_sp & 255u) == 0u) { if (xb_ld(&(bar)[XB_TMO])) break; if (_sp > XB_SPIN_CAP) { atomicAdd(&(bar)[XB_TMO], 1u); break; } } } } while (0)
__device__ __forceinline__ void xcd_barrier_complete(unsigned* bar, unsigned x, unsigned& nloc, unsigned& nx) {
  const unsigned G = gridDim.x;
  unsigned sum, cnt, mine, sp = 0u;
  for (;;) {
    sum = 0u; cnt = 0u; mine = 0u;
#pragma unroll
    for (unsigned j = 0; j < 16; ++j) { const unsigned c = xb_ld(&bar[XB_XCNT(j)]); sum += c; cnt += (c > 0u) ? 1u : 0u; mine = (j == x) ? c : mine; }
    if (sum == G) break;
    __builtin_amdgcn_s_sleep(1);
    if ((++sp & 255u) == 0u) { if (xb_ld(&bar[XB_TMO])) break; if (sp > XB_SPIN_CAP) { atomicAdd(&bar[XB_TMO], 1u); break; } }
  }
  nloc = mine > 0u ? mine : 1u; nx = cnt > 0u ? cnt : 1u;
}
__device__ __forceinline__ void grid_bar(unsigned* bar, volatile LAS unsigned* st) {
  asm volatile("s_waitcnt vmcnt(0)" ::: "memory");
  __syncthreads();
  if (threadIdx.x == 0) {
    __builtin_amdgcn_s_waitcnt(0);
    const unsigned x = xb_xcc_id();
    unsigned nloc = st[0], nx = st[1];
    if (nloc == 0u) { xcd_barrier_complete(bar, x, nloc, nx); st[0] = nloc; st[1] = nx; }
    const unsigned old = xb_add(&bar[XB_XSUB(x)], 1u);
    const unsigned gen = old / nloc;
    if (old + 1u == (gen + 1u) * nloc) {
      __builtin_amdgcn_fence(__ATOMIC_RELEASE, "agent");
      asm volatile("s_waitcnt vmcnt(0)" ::: "memory");
      const unsigned og = xb_add(&bar[XB_TOP], 1u);
      const unsigned tg = og / nx;
      if (og + 1u == (tg + 1u) * nx) xb_add(&bar[XB_TOPGEN], 1u);
      else XB_SPIN(xb_ld(&bar[XB_TOPGEN]) == tg, bar);
      __builtin_amdgcn_fence(__ATOMIC_ACQUIRE, "agent");
      xb_add(&bar[XB_XGEN(x)], 1u);
      asm volatile("s_waitcnt vmcnt(0)" ::: "memory");
    } else {
      XB_SPIN(xb_ld(&bar[XB_XGEN(x)]) == gen, bar);
      __builtin_amdgcn_fence(__ATOMIC_ACQUIRE, "agent");
      asm volatile("s_waitcnt vmcnt(0)" ::: "memory");
    }
  }
  __syncthreads();
}
typedef const float* cfp_t;
typedef const cfp_t __attribute__((address_space(4)))* kargp_t;
__device__ __forceinline__ void run_phase_fresh(int ph, unsigned char* lds) {
  kargp_t q = (kargp_t)__builtin_amdgcn_kernarg_segment_ptr();
  asm volatile("" : "+s"(q));
  Params lp;
  lp.xp = q[0];
  lp.xs = q[1];
  lp.cp = q[2];
  lp.cs = q[3];
  lp.w_ada = q[4];
  lp.b_ada = q[5];
  lp.g_pre_mix = q[6];
  lp.g_post_mix = q[7];
  lp.g_pre_ffn = q[8];
  lp.g_post_ffn = q[9];
  lp.w_in = q[10];
  lp.sgu_norm = q[11];
  lp.sgu_w = q[12];
  lp.sgu_b = q[13];
  lp.dec_f = q[14];
  lp.dec_b = q[15];
  lp.sink = q[16];
  lp.w_out = q[17];
  lp.w_up = q[18];
  lp.conv_w = q[19];
  lp.conv_b = q[20];
  lp.w_down = q[21];
  lp.out = (float*)q[22];
  lp.ws = (unsigned char*)q[23];
  run_phase(lp, ph, lds);
}
__global__ void __launch_bounds__(512, 2) mega_kernel(Params p, int ph_lo, int ph_hi) {
  unsigned char* lds = dyn_lds;
  cg::grid_group grid = cg::this_grid();
#if N_LAUNCH_MODE == 1
  unsigned* bar = (unsigned*)((unsigned char*)((kargp_t)__builtin_amdgcn_kernarg_segment_ptr())[23] + OFF_BAR);
  __shared__ u32x4 xb_words;
  if (threadIdx.x == 0) xb_words = u32x4{0u, 0u, 0u, 0u};
  __syncthreads();
  volatile LAS unsigned* st = (volatile LAS unsigned*)&xb_words;
  if (threadIdx.x == 0) (void)xb_add(&bar[XB_XCNT(xb_xcc_id())], 1u);
  run_phase_fresh(0, lds);
#ifdef REP0
  run_phase_fresh(0, lds); grid.sync(); run_phase_fresh(0, lds); grid.sync();
#endif
  run_phase_fresh(1, lds); grid.sync();
#ifdef STOP_PH
#define PHS(n) if (n <= STOP_PH) { run_phase_fresh(n, lds); grid.sync(); }
#elif defined(REP_PH)
#define PHS(n) run_phase_fresh(n, lds); grid.sync(); if (n == REP_PH) { run_phase_fresh(n, lds); grid.sync(); run_phase_fresh(n, lds); grid.sync(); }
#elif defined(REP_S)
#define PHS(n) run_phase_fresh(n, lds); grid.sync(); if (n >= 2 && (n - 2) % 9 == REP_S) { run_phase_fresh(n, lds); grid.sync(); }
#elif defined(SYNC2)
#define PHS(n) run_phase_fresh(n, lds); grid.sync(); grid.sync(); grid.sync();
#else
#define PHS(n) run_phase_fresh(n, lds); grid_bar(bar, st);
#endif
  PHS(2) PHS(3) PHS(4) PHS(5) PHS(6) PHS(7) PHS(8) PHS(9) PHS(10)
  PHS(11) PHS(12) PHS(13) PHS(14) PHS(15) PHS(16) PHS(17) PHS(18)
#ifdef STOP_PH
  {
    kargp_t q = (kargp_t)__builtin_amdgcn_kernarg_segment_ptr();
    float* o = (float*)q[22]; const bf16_t* b = (const bf16_t*)((const unsigned char*)q[23] + DUMP_OFF);
    for (size_t i = (size_t)blockIdx.x * 256 + threadIdx.x; i < (size_t)T * D; i += (size_t)gridDim.x * 256) o[i] = (i < DUMP_N) ? bf2f(b[i]) : 0.f;
  }
#else
  run_phase_fresh(19, lds);
#endif
  static_assert(NPHASE == 20, "phase list");
#else
  if (ph_lo == 100) {
    float* o = p.out; const float* b = (const float*)(p.ws + DUMP_OFF);
    for (size_t i = (size_t)blockIdx.x * 256 + threadIdx.x; i < (size_t)T * D; i += (size_t)gridDim.x * 256) o[i] = (i < DUMP_N) ? b[i] : 0.f;
    return;
  }
  for (int ph = ph_lo; ph < ph_hi; ++ph) run_phase(p, ph, lds);
#endif
}

extern "C" void kernel_launch(void* const* d_in, const int* in_sizes, int n_in, void* d_out, int out_size, void* d_ws, size_t ws_size,
                              hipStream_t stream) {
  static int grid_blocks = 0;
  if (!grid_blocks) {
    int dev = 0, cus = 0, per_cu = 0;
    hipGetDevice(&dev);
    hipDeviceGetAttribute(&cus, hipDeviceAttributeMultiprocessorCount, dev);
    hipFuncSetAttribute((const void*)mega_kernel, hipFuncAttributeMaxDynamicSharedMemorySize, DYN_LDS);
    hipOccupancyMaxActiveBlocksPerMultiprocessor(&per_cu, (const void*)mega_kernel, 512, DYN_LDS);
    if (per_cu > 1) per_cu = 1;
    if (per_cu < 1) per_cu = 1;
    grid_blocks = cus * per_cu;
  }
  if (ws_size < WS_NEED || n_in != 22) { fprintf(stderr, "kernel_launch: workspace too small (%zu < %zu) or n_in %d\n", ws_size, (size_t)WS_END, n_in); return; }
  Params p{};
  const float** pp = (const float**)&p;
  for (int i = 0; i < 22; ++i) pp[i] = (const float*)d_in[i];
  p.out = (float*)d_out;
  p.ws = (unsigned char*)d_ws;
#if N_LAUNCH_MODE == 1
  hipMemsetAsync((unsigned char*)d_ws + OFF_BAR, 0, BAR_BYTES, stream);
  int lo = 0, hi = NPHASE;
  void* args[] = {&p, &lo, &hi};
  hipError_t e = hipLaunchCooperativeKernel((const void*)mega_kernel, dim3(grid_blocks), dim3(512), args, DYN_LDS, stream);
  if (e != hipSuccess) fprintf(stderr, "cooperative launch failed: %s (grid %d)\n", hipGetErrorString(e), grid_blocks);
#else
#ifdef STOP_PH
  for (int ph = 0; ph <= STOP_PH; ++ph) hipLaunchKernelGGL(mega_kernel, dim3(grid_blocks), dim3(512), DYN_LDS, stream, p, ph, ph + 1);
  hipLaunchKernelGGL(mega_kernel, dim3(grid_blocks), dim3(512), DYN_LDS, stream, p, 100, 101);
#else
  for (int ph = 0; ph < NPHASE; ++ph) hipLaunchKernelGGL(mega_kernel, dim3(grid_blocks), dim3(512), DYN_LDS, stream, p, ph, ph + 1);
#endif
#endif
}
```

```cpp
#include <hip/hip_runtime.h>
#include <hip/hip_cooperative_groups.h>
#include <cstdio>
#include <cstdint>
namespace cg = cooperative_groups;

#define EPI_VARIANT 0
#define PANEL_H 4
#ifndef N_LAUNCH_MODE
#define N_LAUNCH_MODE 1
#endif

typedef unsigned short bf16_t;
typedef __attribute__((ext_vector_type(8))) short bf16x8;
typedef __attribute__((ext_vector_type(16))) float f32x16;
typedef __attribute__((ext_vector_type(4))) float f32x4;
typedef __attribute__((ext_vector_type(4))) unsigned u32x4;
typedef __attribute__((ext_vector_type(2))) unsigned u32x2;

constexpr int D = 1024, T = 49152, TP = 16384, IN_DIM = 2688, DFF = 2816, NCH = 384, NB = 18, DEPTH = 2;
constexpr float EPS = 1e-6f;
constexpr int LDS_BYTES = 36864;
constexpr int DYN_LDS = 131072;

constexpr int NPHASE = 2 + 9 * DEPTH;

constexpr size_t SZ_WIN = (size_t)IN_DIM * D * 2, SZ_WOUT = (size_t)D * D * 2, SZ_WUP = (size_t)2 * DFF * D * 2, SZ_WDOWN = (size_t)D * DFF * 2, SZ_SGUW = 4 * 128 * 128 * 2;
constexpr size_t OFF_WIN = 0, OFF_WOUT = OFF_WIN + SZ_WIN, OFF_WUP = OFF_WOUT + SZ_WOUT, OFF_WDOWN = OFF_WUP + SZ_WUP, OFF_SGUW = OFF_WDOWN + SZ_WDOWN;
constexpr size_t SZ_WLAYER = OFF_SGUW + SZ_SGUW;
constexpr size_t OFF_MOD = SZ_WLAYER * DEPTH;
constexpr size_t OFF_ROPER_ = OFF_MOD + (size_t)DEPTH * NB * 6 * D * 4;
constexpr size_t OFF_ROPEA = OFF_ROPER_ + (size_t)8192 * 32 * 8;
constexpr size_t OFF_RA = OFF_ROPEA + (size_t)8192 * 8 * 8;
constexpr size_t OFF_RB = OFF_RA + (size_t)T * D * 2;
constexpr size_t OFF_RC = OFF_RB + (size_t)T * DFF * 2;
constexpr size_t WS_END = OFF_RC + (size_t)T * D * 2;
constexpr size_t OFF_ZERO = WS_END;
constexpr size_t OFF_BAR = WS_END + 8192;
constexpr size_t BAR_BYTES = 16384;
constexpr size_t WS_NEED = OFF_BAR + BAR_BYTES;

struct Params {
  const float *xp, *xs, *cp, *cs, *w_ada, *b_ada, *g_pre_mix, *g_post_mix, *g_pre_ffn, *g_post_ffn, *w_in, *sgu_norm, *sgu_w, *sgu_b,
      *dec_f, *dec_b, *sink, *w_out, *w_up, *conv_w, *conv_b, *w_down;
  float* out;
  unsigned char* ws;
};

__device__ __forceinline__ int tid_() { int t = threadIdx.x; asm volatile("" : "+v"(t)); return t; }
typedef __bf16 bf16x2_t __attribute__((ext_vector_type(2)));
typedef float f32x2_t __attribute__((ext_vector_type(2)));
__device__ __forceinline__ unsigned pack2(float lo, float hi) {
  f32x2_t v = {lo, hi};
  bf16x2_t b = __builtin_convertvector(v, bf16x2_t);
  return __builtin_bit_cast(unsigned, b);
}
__device__ __forceinline__ bf16_t f2bf(float f) { __bf16 b = (__bf16)f; return __builtin_bit_cast(unsigned short, b); }
__device__ __forceinline__ float bf2f(unsigned h) { return __uint_as_float(h << 16); }
__device__ __forceinline__ float bflo(unsigned u) { return __uint_as_float(u << 16); }
__device__ __forceinline__ float bfhi(unsigned u) { return __uint_as_float(u & 0xffff0000u); }
__device__ __forceinline__ float fexp2(float x) { return __builtin_amdgcn_exp2f(x); }
__device__ __forceinline__ float frcp(float x) { return __builtin_amdgcn_rcpf(x); }
__device__ __forceinline__ float gelu_t(float x) {
  const float u = 0.7978845608028654f * (x + 0.044715f * x * x * x);
  return x * frcp(1.f + fexp2(-2.885390081777927f * u));
}
__device__ __forceinline__ float silu_f(float x) { return x * frcp(1.f + fexp2(-1.4426950408889634f * x)); }
__device__ __forceinline__ float wave_sum(float v) {
#pragma unroll
  for (int o = 1; o < 64; o <<= 1) v += __shfl_xor(v, o);
  return v;
}
__device__ __forceinline__ float half_sum(float v) {
#pragma unroll
  for (int o = 1; o < 32; o <<= 1) v += __shfl_xor(v, o);
  return v;
}
__device__ __forceinline__ float half_max(float v) {
#pragma unroll
  for (int o = 1; o < 32; o <<= 1) v = fmaxf(v, __shfl_xor(v, o));
  return v;
}
__device__ __forceinline__ int pos_of(int t) { return t < TP ? (t & 8191) : ((t - TP) & 2047); }
__device__ __forceinline__ int batch_of(int t) { return t < TP ? (t >> 13) : 2 + ((t - TP) >> 11); }
__device__ __forceinline__ int crow(int reg, int lane) { return (reg & 3) + 8 * (reg >> 2) + 4 * (lane >> 5); }
__device__ __forceinline__ f32x16 mfma32(bf16x8 a, bf16x8 b, f32x16 c) { return __builtin_amdgcn_mfma_f32_32x32x16_bf16(a, b, c, 0, 0, 0); }
__device__ __forceinline__ f32x16 zero16() { f32x16 z;
#pragma unroll
  for (int i = 0; i < 16; ++i) z[i] = 0.f;
  return z; }

__device__ __forceinline__ void wave_lds_fence() { asm volatile("s_waitcnt lgkmcnt(0)" ::: "memory"); }
__device__ __forceinline__ void mma_rt(const bf16x8* afr, const bf16_t* sB, f32x16* acc, int lane) {
#pragma unroll
  for (int s = 0; s < 4; ++s) {
#pragma unroll
    for (int n2 = 0; n2 < 2; ++n2) {
      const bf16x8 b = *(const bf16x8*)(sB + (n2 * 32 + (lane & 31)) * 72 + s * 16 + (lane >> 5) * 8);
      acc[n2] = mfma32(afr[s], b, acc[n2]);
    }
  }
}
__device__ __forceinline__ void stage_rows_bf16(bf16_t* dst, const bf16_t* src, int ld) {
  const int t = tid_() & 255, r = t >> 2, q = t & 3;
  const u32x4* s = (const u32x4*)(src + (size_t)r * ld + q * 16);
  u32x4 a = s[0], b = s[1];
  u32x4* d = (u32x4*)(dst + r * 72 + q * 16);
  d[0] = a; d[1] = b;
}
__device__ __forceinline__ void stage_T_bf16(bf16_t* dst, const bf16_t* src, int ld, float rowscale) {
  const int t = tid_() & 255, j = t & 63, q = t >> 6;
  const u32x4* s = (const u32x4*)(src + (size_t)j * ld + q * 16);
  u32x4 a = s[0], b = s[1];
  unsigned w[8] = {a.x, a.y, a.z, a.w, b.x, b.y, b.z, b.w};
#pragma unroll
  for (int i = 0; i < 8; ++i) {
    dst[(q * 16 + 2 * i) * 72 + j] = f2bf(bflo(w[i]) * rowscale);
    dst[(q * 16 + 2 * i + 1) * 72 + j] = f2bf(bfhi(w[i]) * rowscale);
  }
}
__device__ __forceinline__ void ldg_rows(u32x4 (&r)[2], const bf16_t* src, int ld) {
  const int t = tid_() & 255, row = t >> 2, q = t & 3;
  const u32x4* s = (const u32x4*)(src + (size_t)row * ld + q * 16);
  r[0] = s[0]; r[1] = s[1];
}
__device__ __forceinline__ void sts_rows(bf16_t* dst, const u32x4 (&r)[2]) {
  const int t = tid_() & 255, row = t >> 2, q = t & 3;
  u32x4* d = (u32x4*)(dst + row * 72 + q * 16);
  d[0] = r[0]; d[1] = r[1];
}
__device__ __forceinline__ void sts_T(bf16_t* dst, const u32x4 (&r)[2], float rowscale) {
  const int t = tid_() & 255, j = t >> 2, q = t & 3;
  const unsigned w[8] = {r[0].x, r[0].y, r[0].z, r[0].w, r[1].x, r[1].y, r[1].z, r[1].w};
#pragma unroll
  for (int i = 0; i < 8; ++i) {
    dst[(q * 16 + 2 * i) * 72 + j] = f2bf(bflo(w[i]) * rowscale);
    dst[(q * 16 + 2 * i + 1) * 72 + j] = f2bf(bfhi(w[i]) * rowscale);
  }
}
__device__ __forceinline__ void ldg_rowsT(u32x4 (&r)[2], const bf16_t* src, int ld) {
  const int t = tid_() & 255, row = t & 63, q = t >> 6;
  const u32x4* s = (const u32x4*)(src + (size_t)row * ld + q * 16);
  r[0] = s[0]; r[1] = s[1];
}
__device__ __forceinline__ void sts_T_raw(bf16_t* dst, const u32x4 (&r)[2]) {
  const int t = tid_() & 255, j = t & 63, q = t >> 6;
  const unsigned w[8] = {r[0].x, r[0].y, r[0].z, r[0].w, r[1].x, r[1].y, r[1].z, r[1].w};
#pragma unroll
  for (int i = 0; i < 8; ++i) {
    dst[(q * 16 + 2 * i) * 72 + j] = (bf16_t)(w[i] & 0xffffu);
    dst[(q * 16 + 2 * i + 1) * 72 + j] = (bf16_t)(w[i] >> 16);
  }
}
__device__ __forceinline__ void stage_rows_f32(bf16_t* dst, const float* src) {
  const int t = tid_() & 255, r = t >> 2, q = t & 3;
  const f32x4* s = (const f32x4*)(src + r * 64 + q * 16);
  f32x4 a = s[0], b = s[1], c = s[2], d = s[3];
  u32x4 o0, o1;
  o0.x = pack2(a[0], a[1]); o0.y = pack2(a[2], a[3]); o0.z = pack2(b[0], b[1]); o0.w = pack2(b[2], b[3]);
  o1.x = pack2(c[0], c[1]); o1.y = pack2(c[2], c[3]); o1.z = pack2(d[0], d[1]); o1.w = pack2(d[2], d[3]);
  u32x4* dd = (u32x4*)(dst + r * 72 + q * 16);
  dd[0] = o0; dd[1] = o1;
}

__device__ __forceinline__ void tile_load(bf16_t* s, const bf16_t* g, int ld, int lane) {
  wave_lds_fence();
#pragma unroll
  for (int i = 0; i < 4; ++i) {
    const int row = (lane >> 3) + 8 * i, ch = lane & 7;
    *(u32x4*)(s + row * 72 + ch * 8) = *(const u32x4*)(g + (size_t)row * ld + ch * 8);
  }
  wave_lds_fence();
}
__device__ __forceinline__ void tile_store(bf16_t* g, int ld, const bf16_t* s, int lane) {
  wave_lds_fence();
#pragma unroll
  for (int i = 0; i < 4; ++i) {
    const int row = (lane >> 3) + 8 * i, ch = lane & 7;
    *(u32x4*)(g + (size_t)row * ld + ch * 8) = *(const u32x4*)(s + row * 72 + ch * 8);
  }
  wave_lds_fence();
}
__device__ __forceinline__ void transpose_item(const float* W, int K, int N, bf16_t* Wt, int item, float* scr) {
  const int nblk = N / 64, kb = item / nblk, nb = item % nblk, k0 = kb * 64, n0 = nb * 64, t = tid_() & 255;
  __syncthreads();
#pragma unroll
  for (int i = 0; i < 4; ++i) {
    const int kk = (t >> 4) + 16 * i, c4 = (t & 15) * 4;
    const f32x4 v = *(const f32x4*)(W + (size_t)(k0 + kk) * N + n0 + c4);
    scr[kk * 65 + c4 + 0] = v[0]; scr[kk * 65 + c4 + 1] = v[1]; scr[kk * 65 + c4 + 2] = v[2]; scr[kk * 65 + c4 + 3] = v[3];
  }
  __syncthreads();
  const int n = t >> 2, q = t & 3;
  unsigned pk[8];
#pragma unroll
  for (int i = 0; i < 8; ++i) pk[i] = pack2(scr[(q * 16 + 2 * i) * 65 + n], scr[(q * 16 + 2 * i + 1) * 65 + n]);
  u32x4* dst = (u32x4*)(Wt + (size_t)(n0 + n) * K + k0 + q * 16);
  u32x4 o0, o1; o0.x = pk[0]; o0.y = pk[1]; o0.z = pk[2]; o0.w = pk[3]; o1.x = pk[4]; o1.y = pk[5]; o1.z = pk[6]; o1.w = pk[7];
  dst[0] = o0; dst[1] = o1;
}

__device__ __forceinline__ void mod_item(const Params& p, int item, float* lds) {
  const int l = item / 96, jb = item % 96, t = tid_() & 255, lane = t & 63, wave = __builtin_amdgcn_readfirstlane(t >> 6);
  float* sc = lds;
  float* red = lds + 18 * 256;
  const float* W = p.w_ada + (size_t)l * D * 6 * D + jb * 64 + lane;
  float acc[NB];
#pragma unroll
  for (int b = 0; b < NB; ++b) acc[b] = 0.f;
  for (int kq = 0; kq < 4; ++kq) {
    __syncthreads();
#pragma unroll
    for (int b = 0; b < NB; ++b) {
      const float c = (b < 2) ? p.cp[b * D + kq * 256 + t] : p.cs[(b - 2) * D + kq * 256 + t];
      sc[b * 256 + t] = silu_f(c);
    }
    __syncthreads();
#pragma unroll 8
    for (int kk = 0; kk < 64; ++kk) {
      const int kl = wave * 64 + kk;
      const float w = W[(size_t)(kq * 256 + kl) * (6 * D)];
#pragma unroll
      for (int b = 0; b < NB; ++b) acc[b] += sc[b * 256 + kl] * w;
    }
  }
#pragma unroll
  for (int b = 0; b < NB; ++b) red[(wave * NB + b) * 64 + lane] = acc[b];
  __syncthreads();
  float* mod = (float*)(p.ws + OFF_MOD);
  for (int idx = t; idx < NB * 64; idx += 256) {
    const int b = idx >> 6, jj = idx & 63;
    const float s = red[(0 * NB + b) * 64 + jj] + red[(1 * NB + b) * 64 + jj] + red[(2 * NB + b) * 64 + jj] + red[(3 * NB + b) * 64 + jj];
    mod[(size_t)(l * NB + b) * 6 * D + jb * 64 + jj] = s + p.b_ada[l * 6 * D + jb * 64 + jj];
  }
}

__device__ __forceinline__ void phase_setup(const Params& p, unsigned char* lds) {
  constexpr int I_MOD = 192, I_TL = 672 + 256 + 1408 + 704, I_T = I_TL * DEPTH, I_SGU = 64, I_RR = 2, I_RA = 0;
  constexpr int NIT = I_MOD + I_T + I_SGU + I_RR + I_RA;
  const int t = tid_() & 255, half = __builtin_amdgcn_readfirstlane(tid_() >> 8);
  lds += half * LDS_BYTES;
  for (int it = blockIdx.x * 2 + half; it < NIT; it += gridDim.x * 2) {
    int r = it;
    if (r < I_MOD) { mod_item(p, r, (float*)lds); __syncthreads(); continue; }
    r -= I_MOD;
    if (r < I_T) {
      const int l = r / I_TL; r %= I_TL;
      unsigned char* wl = p.ws + SZ_WLAYER * l;
      if (r < 672) { transpose_item(p.w_in + (size_t)l * D * IN_DIM, D, IN_DIM, (bf16_t*)(wl + OFF_WIN), r, (float*)lds); continue; }
      r -= 672;
      if (r < 256) { transpose_item(p.w_out + (size_t)l * D * D, D, D, (bf16_t*)(wl + OFF_WOUT), r, (float*)lds); continue; }
      r -= 256;
      if (r < 1408) { transpose_item(p.w_up + (size_t)l * D * 2 * DFF, D, 2 * DFF, (bf16_t*)(wl + OFF_WUP), r, (float*)lds); continue; }
      r -= 1408;
      transpose_item(p.w_down + (size_t)l * DFF * D, DFF, D, (bf16_t*)(wl + OFF_WDOWN), r, (float*)lds);
      continue;
    }
    r -= I_T;
    if (r < I_SGU) {
      const int l = r / 32, rr = r % 32;
      const float* src = p.sgu_w + (size_t)l * 65536 + rr * 2048 + t * 8;
      bf16_t* dst = (bf16_t*)(p.ws + SZ_WLAYER * l + OFF_SGUW) + rr * 2048 + t * 8;
      const f32x4 a = *(const f32x4*)src, b = *(const f32x4*)(src + 4);
      u32x4 o; o.x = pack2(a[0], a[1]); o.y = pack2(a[2], a[3]); o.z = pack2(b[0], b[1]); o.w = pack2(b[2], b[3]);
      *(u32x4*)dst = o;
      continue;
    }
    r -= I_SGU;
    {
      ((u32x4*)(p.ws + OFF_ZERO))[r * 256 + t] = u32x4{0u, 0u, 0u, 0u};
    }
  }
}

constexpr int NR = 2;
__device__ __forceinline__ void norm_load(const Params& p, int l, int kind, int t0, int lane, f32x4 (&xv)[NR][4], u32x2 (&xu)[NR][4], u32x2 (&yu)[NR][4]) {
  const bool x_f32 = (l == 0) && (kind != 2);
  const bf16_t* xb = kind == 2 ? (const bf16_t*)(p.ws + OFF_RC) : (const bf16_t*)p.out;
  const bf16_t* ybuf = (const bf16_t*)(p.ws + (kind == 2 ? OFF_RA : OFF_RC));
#pragma unroll
  for (int r = 0; r < NR; ++r) {
    const int t = t0 + r;
    if (x_f32) {
      const float* xrow = t < TP ? p.xp + (size_t)t * D : p.xs + (size_t)(t - TP) * D;
#pragma unroll
      for (int j = 0; j < 4; ++j) xv[r][j] = __builtin_nontemporal_load((const f32x4*)(xrow + (lane + 64 * j) * 4));
    } else {
#pragma unroll
      for (int j = 0; j < 4; ++j) xu[r][j] = __builtin_nontemporal_load((const u32x2*)(xb + (size_t)t * D + (lane + 64 * j) * 4));
    }
    if (kind != 0) {
#pragma unroll
      for (int j = 0; j < 4; ++j) yu[r][j] = __builtin_nontemporal_load((const u32x2*)(ybuf + (size_t)t * D + (lane + 64 * j) * 4));
    }
  }
}
__device__ __forceinline__ void norm_rows(const Params& p, int l, int kind, int t0, int lane, f32x4 (&xv)[NR][4], u32x2 (&xu)[NR][4], u32x2 (&yu)[NR][4]) {
  constexpr int R = NR;
  const float* modb = (const float*)(p.ws + OFF_MOD);
  bf16_t* hbuf = (bf16_t*)(p.ws + OFF_RA);
  const int b = batch_of(t0);
  const float* mod = modb + (size_t)(l * NB + b) * 6 * D;
  int hl = l;
  int sh_off = 0, sc_off = D;
  const float* gpre = p.g_pre_mix;
  if (!((l == 0) && (kind != 2))) {
#pragma unroll
    for (int r = 0; r < R; ++r)
#pragma unroll
      for (int j = 0; j < 4; ++j) { xv[r][j][0] = bflo(xu[r][j].x); xv[r][j][1] = bfhi(xu[r][j].x); xv[r][j][2] = bflo(xu[r][j].y); xv[r][j][3] = bfhi(xu[r][j].y); }
  }
  if (kind != 0) {
    float rs[R];
#pragma unroll
    for (int r = 0; r < R; ++r) {
      float ss = 0.f;
#pragma unroll
      for (int j = 0; j < 4; ++j) {
        const float a0 = bflo(yu[r][j].x), a1 = bfhi(yu[r][j].x), a2 = bflo(yu[r][j].y), a3 = bfhi(yu[r][j].y);
        ss += a0 * a0 + a1 * a1 + a2 * a2 + a3 * a3;
      }
      rs[r] = ss;
    }
#pragma unroll
    for (int o = 1; o < 64; o <<= 1)
#pragma unroll
      for (int r = 0; r < R; ++r) rs[r] += __shfl_xor(rs[r], o);
#pragma unroll
    for (int r = 0; r < R; ++r) rs[r] = rsqrtf(rs[r] * (1.f / D) + EPS);
    const float* gpost = (kind == 1 ? p.g_post_mix : p.g_post_ffn) + l * D;
    const float* gt = mod + (kind == 1 ? 2 * D : 5 * D);
    const bool last = (kind == 2) && (l + 1 >= DEPTH);
    bf16_t* xbo = kind == 1 ? (bf16_t*)(p.ws + OFF_RC) : (bf16_t*)p.out;
#pragma unroll
    for (int j = 0; j < 4; ++j) {
      const int c = (lane + 64 * j) * 4;
      const f32x4 g = *(const f32x4*)(gpost + c), gg = *(const f32x4*)(gt + c);
#pragma unroll
      for (int r = 0; r < R; ++r) {
        const float y0 = bflo(yu[r][j].x), y1 = bfhi(yu[r][j].x), y2 = bflo(yu[r][j].y), y3 = bfhi(yu[r][j].y);
        xv[r][j][0] += gg[0] * (y0 * rs[r] * g[0]); xv[r][j][1] += gg[1] * (y1 * rs[r] * g[1]);
        xv[r][j][2] += gg[2] * (y2 * rs[r] * g[2]); xv[r][j][3] += gg[3] * (y3 * rs[r] * g[3]);
        if (last) __builtin_nontemporal_store(xv[r][j], (f32x4*)(p.out + (size_t)(t0 + r) * D + c));
        else { u32x2 o2; o2.x = pack2(xv[r][j][0], xv[r][j][1]); o2.y = pack2(xv[r][j][2], xv[r][j][3]); __builtin_nontemporal_store(o2, (u32x2*)(xbo + (size_t)(t0 + r) * D + c)); }
      }
    }
    if (kind == 1) { sh_off = 3 * D; sc_off = 4 * D; gpre = p.g_pre_ffn; }
    else { hl = l + 1; if (hl >= DEPTH) return; mod = modb + (size_t)(hl * NB + b) * 6 * D; }
  }
  float rx[R];
#pragma unroll
  for (int r = 0; r < R; ++r) {
    float ss = 0.f;
#pragma unroll
    for (int j = 0; j < 4; ++j) ss += xv[r][j][0] * xv[r][j][0] + xv[r][j][1] * xv[r][j][1] + xv[r][j][2] * xv[r][j][2] + xv[r][j][3] * xv[r][j][3];
    rx[r] = ss;
  }
#pragma unroll
  for (int o = 1; o < 64; o <<= 1)
#pragma unroll
    for (int r = 0; r < R; ++r) rx[r] += __shfl_xor(rx[r], o);
#pragma unroll
  for (int r = 0; r < R; ++r) rx[r] = rsqrtf(rx[r] * (1.f / D) + EPS);
#pragma unroll
  for (int j = 0; j < 4; ++j) {
    const int c = (lane + 64 * j) * 4;
    const f32x4 g = *(const f32x4*)(gpre + hl * D + c), sc = *(const f32x4*)(mod + sc_off + c), sh = *(const f32x4*)(mod + sh_off + c);
#pragma unroll
    for (int r = 0; r < R; ++r) {
      float h[4];
#pragma unroll
      for (int e = 0; e < 4; ++e) h[e] = xv[r][j][e] * rx[r] * g[e] * (1.f + sc[e]) + sh[e];
      u32x2 o2; o2.x = pack2(h[0], h[1]); o2.y = pack2(h[2], h[3]);
      *(u32x2*)(hbuf + (size_t)(t0 + r) * D + c) = o2;
    }
  }
}
__device__ __forceinline__ void phase_norm(const Params& p, int l, int kind) {
  const int lane = tid_() & 63, wave = __builtin_amdgcn_readfirstlane(tid_() >> 6);
  const int gw = blockIdx.x * 8 + wave, NW = gridDim.x * 8;
  constexpr int NG = T / NR;
  f32x4 xa[NR][4], xb[NR][4]; u32x2 ua[NR][4], ub[NR][4], ya[NR][4], yb[NR][4];
  if (gw < NG) norm_load(p, l, kind, gw * NR, lane, xa, ua, ya);
  for (int g = gw; g < NG; g += 2 * NW) {
    if (g + NW < NG) norm_load(p, l, kind, (g + NW) * NR, lane, xb, ub, yb);
    norm_rows(p, l, kind, g * NR, lane, xa, ua, ya);
    if (g + 2 * NW < NG) norm_load(p, l, kind, (g + 2 * NW) * NR, lane, xa, ua, ya);
    if (g + NW < NG) norm_rows(p, l, kind, (g + NW) * NR, lane, xb, ub, yb);
  }
}

typedef __attribute__((ext_vector_type(4))) float f32x4v;
extern __shared__ __attribute__((aligned(16))) unsigned char dyn_lds[];
namespace g8 {
constexpr int BK = 64, HALF = 128, HT = HALF * BK;
__device__ __forceinline__ int lds_byte(int r, int c) {
  const int st = (r >> 4) * 2 + (c >> 5), rr = r & 15, cc = c & 31, ob = rr * 64 + cc * 2;
  return st * 1024 + (ob ^ (((ob >> 9) & 1) << 5));
}
__device__ __forceinline__ void stage_rc(int b, int& R, int& C) {
  const int st = b / 1024, sb = b % 1024, swz = sb ^ (((sb >> 9) & 1) << 5);
  R = (st >> 1) * 16 + swz / 64; C = (st & 1) * 32 + (swz % 64) / 2;
}
}

template <int KIND>
__device__ __forceinline__ void epi_block(const f32x4v (&a)[4][2], bf16_t* sW, int pos0, float frq, float scl, int u, int fr, int fq) {
#pragma unroll
  for (int m = 0; m < 4; ++m) {
#pragma unroll
    for (int j = 0; j < 4; ++j) {
      float v0 = a[m][0][j], v1 = a[m][1][j];
      if (KIND == 1) { v0 = gelu_t(v0); v1 = gelu_t(v1); }
      if (KIND == 3) { v0 = silu_f(v0); v1 = silu_f(v1); }
      if (KIND == 2) {
        float xr = (float)(pos0 + m * 16 + j) * frq; xr -= floorf(xr);
        const float cx = __builtin_amdgcn_cosf(xr), sx = __builtin_amdgcn_sinf(xr);
        const float o0 = v0 * cx - v1 * sx, o1 = v0 * sx + v1 * cx;
        v0 = o0 * scl; v1 = o1 * scl;
      }
      if (KIND == 4) {
        const float partner = __shfl_xor(v0, 8);
        float xr = (float)(pos0 + m * 16 + j) * frq; xr -= floorf(xr);
        const float cx = __builtin_amdgcn_cosf(xr), sx = __builtin_amdgcn_sinf(xr);
        float o = v0;
        if (u == 0) { if (fr < 8) o = v0 * cx - partner * sx; else o = partner * sx + v0 * cx; }
        v0 = o * scl; v1 = v1 * scl;
      }
      const int rl = m * 16 + fq * 4 + j;
      sW[rl * 40 + fr] = f2bf(v0);
      sW[rl * 40 + 16 + fr] = f2bf(v1);
    }
  }
}

__device__ __forceinline__ void g3_window(int id, int& lo, int& hi, int& ti) {
  if (id < 132) { const int sq = id / 66; ti = id - sq * 66; lo = sq * 8192; hi = lo + 8192; }
  else { const int i2 = id - 132, sq = i2 / 17; ti = i2 - sq * 17; lo = TP + sq * 2048; hi = lo + 2048; }
}
template <int MODE>
__device__ __forceinline__ void g8_setup(const Params& p, int pm, int pn, const bf16_t* A, const bf16_t* Bt, int K, int tid,
                                         unsigned (&uA)[2][2], unsigned (&uB)[2], const char* (&Ab)[2], const char* (&Bb)[2],
                                         int& seq_lo, int& seq_hi, int& pj) {
  using namespace g8;
  seq_lo = 0; seq_hi = T; pj = 0;
  const char* zrow = (const char*)(p.ws + OFF_ZERO);
  Ab[0] = (const char*)A; Ab[1] = (const char*)A + (MODE == 3 ? 0 : (size_t)128 * K * 2);
  Bb[0] = (const char*)Bt; Bb[1] = (const char*)Bt + (size_t)(MODE == 3 ? DFF : 128) * K * 2;
#pragma unroll
  for (int i = 0; i < 2; ++i) {
    int R, C; stage_rc(tid * 16 + i * 8192, R, C);
#pragma unroll
    for (int h = 0; h < 2; ++h) {
      if (MODE == 3) {
        int wlo, whi, wti; g3_window(2 * pm + h, wlo, whi, wti);
        const int ar = wlo + 126 * wti - 1 + R;
        const bool ok = ar >= wlo && ar < whi;
        uA[h][i] = ok ? (unsigned)(ar * K + C) * 2u : (unsigned)(zrow - (const char*)A) + (unsigned)C * 2u;
      } else uA[h][i] = (unsigned)((pm * 256 + R) * K + C) * 2u;
    }
    int br;
    if (MODE == 1) {
      const int wcp = R >> 5, n = (R >> 4) & 1, f = R & 15;
      br = pn * 256 + (wcp >> 1) * 64 + (wcp & 1) * 16 + n * 32 + f;
    } else if (MODE == 3) br = pn * 128 + R;
    else br = pn * 256 + R;
    uB[i] = (unsigned)(br * K + C) * 2u;
  }
}

template <int MODE, bool HALFN = false>
__device__ __forceinline__ void gemm256(const Params& p, int l, int pm, int pn, const bf16_t* A, const bf16_t* Bt, int K,
                                        bool first, bool has_next, int pm_n, int pn_n, size_t out_off) {
  using namespace g8;
  bf16_t* shm = (bf16_t*)dyn_lds;
  const int tid = tid_(), lane = tid & 63, wid = __builtin_amdgcn_readfirstlane(tid >> 6), wr = wid >> 2, wc = wid & 3, fr = lane & 15, fq = lane >> 4;
  int seq_lo, seq_hi, pj;
  unsigned uA[2][2], uB[2];
  const char* Ab[2]; const char* Bb[2];
  g8_setup<MODE>(p, pm, pn, A, Bt, K, tid, uA, uB, Ab, Bb, seq_lo, seq_hi, pj);
#define SA(b, h) (shm + ((b) * 2 + (h)) * HT)
#define SB(b, h) (shm + (4 + (b) * 2 + (h)) * HT)
#define STAGE(P, BASE, OFFS, kt)                                                                                        \
  do {                                                                                                                  \
    const unsigned _ko = (unsigned)((kt) * (BK * 2));           \
    _Pragma("unroll") for (int _i = 0; _i < 2; ++_i) {                                                                  \
      __builtin_amdgcn_global_load_lds((const unsigned*)((BASE) + (size_t)((OFFS)[_i] + _ko)),                          \
                                       (unsigned*)((char*)(P) + tid * 16 + _i * 8192), 16, 0, 0);                       \
    }                                                                                                                   \
  } while (0)
#define LDA(dst, b, h)                                                                                                  \
  _Pragma("unroll") for (int m = 0; m < 4; ++m) _Pragma("unroll") for (int k = 0; k < 2; ++k)                           \
      dst[m][k] = *reinterpret_cast<const bf16x8*>((char*)SA(b, h) + lds_byte(wr * 64 + m * 16 + fr, k * 32 + fq * 8))
#define LDB(dst, b, h)                                                                                                  \
  _Pragma("unroll") for (int n = 0; n < 2; ++n) _Pragma("unroll") for (int k = 0; k < 2; ++k)                           \
      dst[n][k] = *reinterpret_cast<const bf16x8*>((char*)SB(b, h) + lds_byte(wc * 32 + n * 16 + fr, k * 32 + fq * 8))
#define MMA(ai, bj, At_, Bt_)                                                                                           \
  if (!(HALFN && (bj) == 1)) do {       \
    __builtin_amdgcn_s_setprio(1);                                                                                      \
    _Pragma("unroll") for (int m = 0; m < 4; ++m) _Pragma("unroll") for (int n = 0; n < 2; ++n)                         \
        _Pragma("unroll") for (int k = 0; k < 2; ++k) acc[ai][bj][m][n] =                                               \
            __builtin_amdgcn_mfma_f32_16x16x32_bf16(At_[m][k], Bt_[n][k], acc[ai][bj][m][n], 0, 0, 0);                 \
    __builtin_amdgcn_s_setprio(0);                                                                                      \
  } while (0)
#define WAIT_V(n) asm volatile("s_waitcnt vmcnt(" #n ")" ::: "memory")
#define WAIT_L(n) asm volatile("s_waitcnt lgkmcnt(" #n ")" ::: "memory")
#define BAR __builtin_amdgcn_s_barrier()
#define SCHED __builtin_amdgcn_sched_barrier(0)
  f32x4v acc[2][2][4][2];
#pragma unroll
  for (int a = 0; a < 2; ++a)
#pragma unroll
    for (int b = 0; b < 2; ++b)
#pragma unroll
      for (int m = 0; m < 4; ++m)
#pragma unroll
        for (int n = 0; n < 2; ++n) acc[a][b][m][n] = f32x4v{0.f, 0.f, 0.f, 0.f};
  bf16x8 At[4][2], B0[2][2], B1[2][2];
  const int nt = K / BK;
  if (first) {
    WAIT_V(0);
    BAR;
    STAGE(SB(0, 0), Bb[0], uB, 0); STAGE(SA(0, 0), Ab[0], uA[0], 0);
    STAGE(SB(0, 1), Bb[1], uB, 0); STAGE(SA(0, 1), Ab[1], uA[MODE == 3 ? 1 : 0], 0);
  }
  if (wr == 1) BAR;
  WAIT_V(4); BAR;
  STAGE(SB(1, 0), Bb[0], uB, 1); STAGE(SA(1, 0), Ab[0], uA[0], 1); STAGE(SB(1, 1), Bb[1], uB, 1);
  WAIT_V(6); BAR;
  for (int t = 0; t < nt - 2; t += 2) {
    LDB(B0, 0, 0); SCHED; LDA(At, 0, 0); STAGE(SA(1, 1), Ab[1], uA[MODE == 3 ? 1 : 0], t + 1);
    WAIT_L(8); BAR; WAIT_L(0); MMA(0, 0, At, B0); BAR; SCHED;
    LDB(B1, 0, 1); STAGE(SB(0, 0), Bb[0], uB, t + 2);
    BAR; WAIT_L(0); MMA(0, 1, At, B1); BAR;
    LDA(At, 0, 1); STAGE(SA(0, 0), Ab[0], uA[0], t + 2);
    BAR; WAIT_L(0); MMA(1, 0, At, B0); BAR; SCHED;
    STAGE(SB(0, 1), Bb[1], uB, t + 2);
    WAIT_V(6); BAR; MMA(1, 1, At, B1); BAR;
    LDB(B0, 1, 0); SCHED; LDA(At, 1, 0); STAGE(SA(0, 1), Ab[1], uA[MODE == 3 ? 1 : 0], t + 2);
    WAIT_L(8); BAR; WAIT_L(0); MMA(0, 0, At, B0); BAR; SCHED;
    LDB(B1, 1, 1); STAGE(SB(1, 0), Bb[0], uB, t + 3);
    BAR; WAIT_L(0); MMA(0, 1, At, B1); BAR;
    LDA(At, 1, 1); STAGE(SA(1, 0), Ab[0], uA[0], t + 3);
    BAR; WAIT_L(0); MMA(1, 0, At, B0); BAR; SCHED;
    STAGE(SB(1, 1), Bb[1], uB, t + 3);
    WAIT_V(6); BAR; MMA(1, 1, At, B1); BAR;
  }
  { LDB(B0, 0, 0); LDA(At, 0, 0); STAGE(SA(1, 1), Ab[1], uA[MODE == 3 ? 1 : 0], nt - 1);
    BAR; WAIT_L(0); MMA(0, 0, At, B0); BAR;
    LDB(B1, 0, 1); BAR; WAIT_L(0); MMA(0, 1, At, B1); BAR;
    LDA(At, 0, 1); WAIT_V(4); BAR; WAIT_L(0); MMA(1, 0, At, B0); MMA(1, 1, At, B1); BAR; }
  { LDB(B0, 1, 0); LDA(At, 1, 0); WAIT_V(2); BAR; WAIT_L(0); MMA(0, 0, At, B0); BAR;
    LDB(B1, 1, 1); WAIT_V(0); BAR; WAIT_L(0); MMA(0, 1, At, B1); BAR;
    LDA(At, 1, 1); BAR; WAIT_L(0); MMA(1, 0, At, B0); MMA(1, 1, At, B1); BAR; }
  if (wr == 0) BAR;
  const int cp = tid & 63, rg = tid >> 6, c0 = pn * 128 + 2 * cp;
  float kg[2][4], kv[2][4];
  if (MODE == 3) {
    const float* cw = p.conv_w + (size_t)l * 3 * 2 * DFF;
    const float* cb = p.conv_b + (size_t)l * 2 * DFF;
#pragma unroll
    for (int c = 0; c < 2; ++c) {
      kg[c][0] = cw[c0 + c]; kg[c][1] = cw[2 * DFF + c0 + c]; kg[c][2] = cw[4 * DFF + c0 + c]; kg[c][3] = cb[c0 + c];
      kv[c][0] = cw[DFF + c0 + c]; kv[c][1] = cw[3 * DFF + c0 + c]; kv[c][2] = cw[5 * DFF + c0 + c]; kv[c][3] = cb[DFF + c0 + c];
    }
  }
  if (has_next) {
    int s_lo, s_hi, pj2; unsigned nA[2][2], nB[2]; const char* nAb[2]; const char* nBb[2];
    g8_setup<MODE>(p, pm_n, pn_n, A, Bt, K, tid, nA, nB, nAb, nBb, s_lo, s_hi, pj2);
    STAGE(SB(0, 0), nBb[0], nB, 0); STAGE(SA(0, 0), nAb[0], nA[0], 0);
    STAGE(SB(0, 1), nBb[1], nB, 0); STAGE(SA(0, 1), nAb[1], nA[MODE == 3 ? 1 : 0], 0);
  }
#undef SA
#undef SB
#undef STAGE
#undef LDA
#undef LDB
#undef MMA
  if (MODE == 1 || MODE == 2) {
    bf16_t* sW = (bf16_t*)((unsigned char*)shm + (wid < 4 ? 32768 : 98304) + (wid & 3) * 5120);
    bf16_t* outp = (bf16_t*)(p.ws + (MODE == 1 ? OFF_RB : out_off));
    const int ldo = MODE == 1 ? IN_DIM : D;
#pragma unroll
    for (int ai = 0; ai < 2; ++ai) {
      const int row0 = pm * 256 + ai * 128 + wr * 64;
#pragma unroll
      for (int bj = 0; bj < (HALFN ? 1 : 2); ++bj) {
        const int cgi = pn * 4 + bj * 2 + (wc >> 1), u = wc & 1;
        int kind = 0; float scl = 1.f;
        if (MODE == 1) {
          kind = cgi < 8 ? 1 : cgi < 20 ? 2 : cgi < 26 ? 0 : cgi < 32 ? 3 : cgi < 40 ? 4 : 0;
          scl = (cgi >= 14 && cgi < 20) || (cgi >= 32 && cgi < 38) ? 0.125f : 1.f;
        }
        float frq = 0.f;
        if (MODE == 1) {
          if (kind == 2) frq = expf(-9.210340371976184f * (float)(u * 16 + fr) * (2.0f / 64.f)) * 0.15915494309189535f;
          if (kind == 4) frq = expf(-13.122363377404328f * (float)(fr & 7) * (2.0f / 16.f)) * 0.15915494309189535f;
        }
        const int pos0 = pos_of(row0) + fq * 4;
        if (MODE == 1 && kind == 1) epi_block<1>(acc[ai][bj], sW, pos0, frq, scl, u, fr, fq);
        else if (MODE == 1 && kind == 2) epi_block<2>(acc[ai][bj], sW, pos0, frq, scl, u, fr, fq);
        else if (MODE == 1 && kind == 3) epi_block<3>(acc[ai][bj], sW, pos0, frq, scl, u, fr, fq);
        else if (MODE == 1 && kind == 4) epi_block<4>(acc[ai][bj], sW, pos0, frq, scl, u, fr, fq);
        else epi_block<0>(acc[ai][bj], sW, pos0, frq, scl, u, fr, fq);
        wave_lds_fence();
#pragma unroll
        for (int i = 0; i < 4; ++i) {
          const int idx = lane + 64 * i, row = idx >> 2, q = idx & 3;
          int col;
          if (MODE == 1) col = pn * 256 + bj * 128 + (wc >> 1) * 64 + (wc & 1) * 16 + (q >> 1) * 32 + (q & 1) * 8;
          else col = pn * 256 + bj * 128 + wc * 32 + q * 8;
          if (MODE != 1 || col < IN_DIM)
            *(u32x4*)(outp + (size_t)(row0 + row) * ldo + col) = *(const u32x4*)(sW + row * 40 + q * 8);
        }
        wave_lds_fence();
      }
    }
  } else {
    unsigned char* sUg = (unsigned char*)shm + 32768;
    unsigned char* sUv = (unsigned char*)shm + 98304;
    bf16_t* act = (bf16_t*)(p.ws + OFF_RB);
#pragma unroll
    for (int ai = 0; ai < 2; ++ai) {
      if (ai) { WAIT_L(0); BAR; }
#pragma unroll
      for (int bj = 0; bj < 2; ++bj)
#pragma unroll
        for (int m = 0; m < 4; ++m)
#pragma unroll
          for (int n = 0; n < 2; ++n) {
            const int col = wc * 32 + n * 16 + fr, un = wr * 8 + m * 2 + (fq >> 1);
            u32x2 w2; w2.x = pack2(acc[ai][bj][m][n][0], acc[ai][bj][m][n][1]); w2.y = pack2(acc[ai][bj][m][n][2], acc[ai][bj][m][n][3]);
            *(u32x2*)((bj ? sUv : sUg) + col * 256 + ((un ^ (col & 15)) << 4) + (fq & 1) * 8) = w2;
          }
      WAIT_L(0); BAR;
      float outv[2][16];
#pragma unroll
      for (int c = 0; c < 2; ++c) {
        const int col = 2 * cp + c;
        float g[24], v[24];
#pragma unroll
        for (int uu = 0; uu < 3; ++uu) {
          u32x4 qg = u32x4{0u, 0u, 0u, 0u}, qv = qg;
          if (uu < 2 || rg < 7) {
            const int un = rg * 2 + uu;
            qg = *(const u32x4*)(sUg + col * 256 + ((un ^ (col & 15)) << 4));
            qv = *(const u32x4*)(sUv + col * 256 + ((un ^ (col & 15)) << 4));
          }
          g[uu * 8 + 0] = bflo(qg.x); g[uu * 8 + 1] = bfhi(qg.x); g[uu * 8 + 2] = bflo(qg.y); g[uu * 8 + 3] = bfhi(qg.y);
          g[uu * 8 + 4] = bflo(qg.z); g[uu * 8 + 5] = bfhi(qg.z); g[uu * 8 + 6] = bflo(qg.w); g[uu * 8 + 7] = bfhi(qg.w);
          v[uu * 8 + 0] = bflo(qv.x); v[uu * 8 + 1] = bfhi(qv.x); v[uu * 8 + 2] = bflo(qv.y); v[uu * 8 + 3] = bfhi(qv.y);
          v[uu * 8 + 4] = bflo(qv.z); v[uu * 8 + 5] = bfhi(qv.z); v[uu * 8 + 6] = bflo(qv.w); v[uu * 8 + 7] = bfhi(qv.w);
        }
#pragma unroll
        for (int o = 0; o < 16; ++o) {
          const float cgv = kg[c][3] + kg[c][0] * g[o] + kg[c][1] * g[o + 1] + kg[c][2] * g[o + 2];
          const float cvv = kv[c][3] + kv[c][0] * v[o] + kv[c][1] * v[o + 1] + kv[c][2] * v[o + 2];
          outv[c][o] = gelu_t(cgv) * cvv;
        }
      }
      int wlo, whi, wti; g3_window(2 * pm + ai, wlo, whi, wti);
      const int tokb = wlo + 126 * wti + rg * 16;
#pragma unroll
      for (int o = 0; o < 16; ++o) {
        const int tok = tokb + o;
        if (rg * 16 + o < 126 && tok < whi) *(unsigned*)(act + (size_t)tok * DFF + c0) = pack2(outv[0][o], outv[1][o]);
      }
    }
  }
#undef WAIT_V
#undef WAIT_L
#undef BAR
#undef SCHED
}

__device__ __forceinline__ void r1_item(const Params& p, int l, int chunk, int h, unsigned char* lds) {
  bf16_t* sV = (bf16_t*)lds;
  bf16_t* sKf = sV + 64 * 72;
  bf16_t* sKb = sKf + 64 * 72;
  const int t = tid_() & 255, lane = t & 63, wave = __builtin_amdgcn_readfirstlane(t >> 6), dir = wave >> 1, eh = wave & 1;
  const bf16_t* proj = (const bf16_t*)(p.ws + OFF_RB);
  const float zf = p.dec_f[l * 6 + h], zb = p.dec_b[l * 6 + h];
  const float lgf = -log1pf(expf(-zf)) * 1.4426950408889634f, lgb = -log1pf(expf(-zb)) * 1.4426950408889634f;
  f32x16 acc[2]; acc[0] = zero16(); acc[1] = zero16();
  for (int jb = 0; jb < 2; ++jb) {
    const int tok0 = chunk * 128 + jb * 64;
    const int jg = jb * 64 + (t & 63);
    __syncthreads();
    stage_T_bf16(sV, proj + (size_t)tok0 * IN_DIM + 1280 + h * 64, IN_DIM, 1.f);
    stage_T_bf16(sKf, proj + (size_t)tok0 * IN_DIM + 896 + h * 64, IN_DIM, fexp2((float)(127 - jg) * lgf));
    stage_T_bf16(sKb, proj + (size_t)tok0 * IN_DIM + 896 + h * 64, IN_DIM, fexp2((float)jg * lgb));
    __syncthreads();
    bf16x8 afr[4];
#pragma unroll
    for (int s = 0; s < 4; ++s) afr[s] = *(const bf16x8*)(sV + (eh * 32 + (lane & 31)) * 72 + s * 16 + (lane >> 5) * 8);
    mma_rt(afr, dir ? sKb : sKf, acc, lane);
  }
  float* kvs = (float*)(p.ws + OFF_RC) + ((size_t)(chunk * 6 + h) * 2 + dir) * 4096;
#pragma unroll
  for (int n2 = 0; n2 < 2; ++n2)
#pragma unroll
    for (int reg = 0; reg < 16; ++reg) kvs[(eh * 32 + crow(reg, lane)) * 64 + n2 * 32 + (lane & 31)] = acc[n2][reg];
}

__device__ __forceinline__ void phase_scan(const Params& p, int l) {
  float* kvs = (float*)(p.ws + OFF_RC);
  const int total = NB * 6 * 2 * 4096;
  for (int idx = blockIdx.x * 512 + tid_(); idx < total; idx += gridDim.x * 512) {
    const int elem = idx & 4095, r = idx >> 12, dir = r & 1, hh = (r >> 1) % 6, sq = (r >> 1) / 6;
    const int c0 = sq < 2 ? sq * 64 : 128 + (sq - 2) * 16, n = sq < 2 ? 64 : 16;
    const float z = dir ? p.dec_b[l * 6 + hh] : p.dec_f[l * 6 + hh];
    const float cd = exp2f(-log1pf(expf(-z)) * 1.4426950408889634f * 128.f);
    float state = 0.f;
    for (int i0 = 0; i0 < n; i0 += 16) {
      float v[16];
#pragma unroll
      for (int i = 0; i < 16; ++i) {
        const int ci = dir ? (n - 1 - (i0 + i)) : (i0 + i);
        v[i] = kvs[((size_t)((c0 + ci) * 6 + hh) * 2 + dir) * 4096 + elem];
      }
#pragma unroll
      for (int i = 0; i < 16; ++i) {
        const int ci = dir ? (n - 1 - (i0 + i)) : (i0 + i);
        kvs[((size_t)((c0 + ci) * 6 + hh) * 2 + dir) * 4096 + elem] = state;
        state = state * cd + v[i];
      }
    }
  }
}

__device__ __forceinline__ void mix_sgu(const Params& p, int l, int chunk, int unit, unsigned char* lds) {
  bf16_t* sK = (bf16_t*)lds;
  bf16_t* sV = sK + 64 * 72;
  const int t = tid_() & 255, lane = t & 63, wave = __builtin_amdgcn_readfirstlane(t >> 6), cl = lane & 31, hh = lane >> 5;
  bf16_t* sP = sV + 64 * 72 + wave * 32 * 72;
  const bf16_t* proj = (const bf16_t*)(p.ws + OFF_RB);
  bf16_t* ymix = (bf16_t*)(p.ws + OFF_RA);
  const int tok0 = chunk * 128;
  const int rowA = tok0 + wave * 32 + cl;

    const int g = unit;
    const bf16_t* Ws = (const bf16_t*)(p.ws + SZ_WLAYER * l + OFF_SGUW) + (size_t)g * 128 * 128;
    f32x16 acc[2]; acc[0] = zero16(); acc[1] = zero16();
    for (int jb = 0; jb < 2; ++jb) {
      __syncthreads();
      {
        const int j = t >> 2, q = t & 3;
        const u32x4* s = (const u32x4*)(proj + (size_t)(tok0 + jb * 64 + j) * IN_DIM + 256 + g * 64 + q * 16);
        const u32x4 a = s[0], b = s[1];
        const unsigned w[8] = {a.x, a.y, a.z, a.w, b.x, b.y, b.z, b.w};
        float ss = 0.f;
#pragma unroll
        for (int i = 0; i < 8; ++i) { const float lo = bflo(w[i]), hi = bfhi(w[i]); ss += lo * lo + hi * hi; }
        ss += __shfl_xor(ss, 1); ss += __shfl_xor(ss, 2);
        const float rstd = rsqrtf(ss * (1.f / 64.f) + EPS);
        const float* ng = p.sgu_norm + l * 256 + g * 64 + q * 16;
#pragma unroll
        for (int i = 0; i < 8; ++i) {
          sV[(q * 16 + 2 * i) * 72 + j] = f2bf(bflo(w[i]) * rstd * ng[2 * i]);
          sV[(q * 16 + 2 * i + 1) * 72 + j] = f2bf(bfhi(w[i]) * rstd * ng[2 * i + 1]);
        }
      }
      __syncthreads();
      bf16x8 afr[4];
#pragma unroll
      for (int s = 0; s < 4; ++s) afr[s] = *(const bf16x8*)(Ws + (wave * 32 + cl) * 128 + jb * 64 + s * 16 + hh * 8);
      mma_rt(afr, sV, acc, lane);
    }
    const float* sb = p.sgu_b + l * 512 + g * 128 + wave * 32;
    tile_load(sP, proj + (size_t)(tok0 + wave * 32) * IN_DIM + g * 64, IN_DIM, lane);
#pragma unroll
    for (int reg = 0; reg < 16; ++reg) {
      const int r = crow(reg, lane);
      const float bias = sb[r];
#pragma unroll
      for (int n2 = 0; n2 < 2; ++n2) {
        const float u = bf2f(sP[r * 72 + n2 * 32 + cl]);
        sP[r * 72 + n2 * 32 + cl] = f2bf(u * (acc[n2][reg] + bias));
      }
    }
    tile_store(ymix + (size_t)(tok0 + wave * 32) * D + g * 64, D, sP, lane);
}
__device__ __forceinline__ void mix_ret(const Params& p, int l, int chunk, int unit, unsigned char* lds) {
  bf16_t* sK = (bf16_t*)lds;
  bf16_t* sV = sK + 64 * 72;
  const int t = tid_() & 255, lane = t & 63, wave = __builtin_amdgcn_readfirstlane(t >> 6), cl = lane & 31, hh = lane >> 5;
  bf16_t* sP = sV + 64 * 72 + wave * 32 * 72;
  const bf16_t* proj = (const bf16_t*)(p.ws + OFF_RB);
  bf16_t* ymix = (bf16_t*)(p.ws + OFF_RA);
  const int tok0 = chunk * 128;
  const int rowA = tok0 + wave * 32 + cl;

    const int h = unit - 4;
    const float zf = p.dec_f[l * 6 + h], zb = p.dec_b[l * 6 + h];
    const float lgf = -log1pf(expf(-zf)) * 1.4426950408889634f, lgb = -log1pf(expf(-zb)) * 1.4426950408889634f;
    bf16x8 afr[4];
#pragma unroll
    for (int s = 0; s < 4; ++s) afr[s] = *(const bf16x8*)(proj + (size_t)rowA * IN_DIM + 512 + h * 64 + s * 16 + hh * 8);
    f32x16 O[2]; O[0] = zero16(); O[1] = zero16();
    for (int jb = 0; jb < 2; ++jb) {
      __syncthreads();
      stage_rows_bf16(sK, proj + (size_t)(tok0 + jb * 64) * IN_DIM + 896 + h * 64, IN_DIM);
      stage_T_bf16(sV, proj + (size_t)(tok0 + jb * 64) * IN_DIM + 1280 + h * 64, IN_DIM, 1.f);
      __syncthreads();
      f32x16 X[2]; X[0] = zero16(); X[1] = zero16();
#pragma unroll
      for (int s = 0; s < 4; ++s)
#pragma unroll
        for (int tk = 0; tk < 2; ++tk) {
          const bf16x8 a = *(const bf16x8*)(sK + (tk * 32 + cl) * 72 + s * 16 + hh * 8);
          X[tk] = mfma32(a, afr[s], X[tk]);
        }
      int ibase = wave * 32 + cl - jb * 64 - 4 * hh;
      asm volatile("" : "+v"(ibase));
#pragma unroll
      for (int tk = 0; tk < 2; ++tk)
#pragma unroll
        for (int reg = 0; reg < 16; ++reg) {
          const int dd = ibase - tk * 32 - (reg & 3) - 8 * (reg >> 2);
          const float w = dd >= 0 ? fexp2((float)dd * lgf) : fexp2((float)(-dd) * lgb);
          X[tk][reg] *= w;
        }
#pragma unroll
      for (int tk = 0; tk < 2; ++tk)
#pragma unroll
        for (int s2 = 0; s2 < 2; ++s2) {
          u32x4 pb;
          pb.x = pack2(X[tk][8 * s2 + 0], X[tk][8 * s2 + 1]); pb.y = pack2(X[tk][8 * s2 + 2], X[tk][8 * s2 + 3]);
          pb.z = pack2(X[tk][8 * s2 + 4], X[tk][8 * s2 + 5]); pb.w = pack2(X[tk][8 * s2 + 6], X[tk][8 * s2 + 7]);
          const bf16x8 bfrag = __builtin_bit_cast(bf16x8, pb);
#pragma unroll
          for (int te = 0; te < 2; ++te) {
            const bf16_t* vp = sV + (te * 32 + cl) * 72 + tk * 32 + s2 * 16 + 4 * hh;
            const u32x2 v0 = *(const u32x2*)vp, v1 = *(const u32x2*)(vp + 8);
            u32x4 va; va.x = v0.x; va.y = v0.y; va.z = v1.x; va.w = v1.y;
            O[te] = mfma32(__builtin_bit_cast(bf16x8, va), bfrag, O[te]);
          }
        }
    }
    __syncthreads();
    const float* kvs = (const float*)(p.ws + OFF_RC) + ((size_t)(chunk * 6 + h) * 2) * 4096;
    stage_rows_f32(sK, kvs);
    stage_rows_f32(sV, kvs + 4096);
    __syncthreads();
    f32x16 Cf[2], Cb[2]; Cf[0] = zero16(); Cf[1] = zero16(); Cb[0] = zero16(); Cb[1] = zero16();
#pragma unroll
    for (int s = 0; s < 4; ++s)
#pragma unroll
      for (int te = 0; te < 2; ++te) {
        const bf16x8 af = *(const bf16x8*)(sK + (te * 32 + cl) * 72 + s * 16 + hh * 8);
        const bf16x8 ab = *(const bf16x8*)(sV + (te * 32 + cl) * 72 + s * 16 + hh * 8);
        Cf[te] = mfma32(af, afr[s], Cf[te]);
        Cb[te] = mfma32(ab, afr[s], Cb[te]);
      }
    tile_load(sP, proj + (size_t)(tok0 + wave * 32) * IN_DIM + 1664 + h * 64, IN_DIM, lane);
    {
      const int i = wave * 32 + cl;
      const float wf = fexp2((float)(i + 1) * lgf), wb = fexp2((float)(128 - i) * lgb);
      float ssum = 0.f;
#pragma unroll
      for (int te = 0; te < 2; ++te)
#pragma unroll
        for (int reg = 0; reg < 16; ++reg) { const float y = O[te][reg] + wf * Cf[te][reg] + wb * Cb[te][reg]; O[te][reg] = y; ssum += y; }
      const float mu = (ssum + __shfl_xor(ssum, 32)) * (1.f / 64.f);
      float vsum = 0.f;
#pragma unroll
      for (int te = 0; te < 2; ++te)
#pragma unroll
        for (int reg = 0; reg < 16; ++reg) { const float dlt = O[te][reg] - mu; O[te][reg] = dlt; vsum += dlt * dlt; }
      const float rstd = rsqrtf((vsum + __shfl_xor(vsum, 32)) * (1.f / 64.f) + EPS);
#pragma unroll
      for (int te = 0; te < 2; ++te)
#pragma unroll
        for (int g4 = 0; g4 < 4; ++g4) {
          bf16_t* gp = sP + cl * 72 + te * 32 + 8 * g4 + 4 * hh;
          const u32x2 gq = *(const u32x2*)gp;
          u32x2 o2;
          o2.x = pack2(O[te][4 * g4 + 0] * rstd * bflo(gq.x), O[te][4 * g4 + 1] * rstd * bfhi(gq.x));
          o2.y = pack2(O[te][4 * g4 + 2] * rstd * bflo(gq.y), O[te][4 * g4 + 3] * rstd * bfhi(gq.y));
          *(u32x2*)gp = o2;
        }
    }
    tile_store(ymix + (size_t)(tok0 + wave * 32) * D + 256 + h * 64, D, sP, lane);
}
__device__ __forceinline__ void mix_att(const Params& p, int l, int chunk, int unit, unsigned char* lds) {
  bf16_t* sK = (bf16_t*)lds;
  bf16_t* sV = sK + 64 * 72;
  const int t = tid_() & 255, lane = t & 63, wave = __builtin_amdgcn_readfirstlane(t >> 6), cl = lane & 31, hh = lane >> 5;
  bf16_t* sP = sV + 64 * 72 + wave * 32 * 72;
  const bf16_t* proj = (const bf16_t*)(p.ws + OFF_RB);
  bf16_t* ymix = (bf16_t*)(p.ws + OFF_RA);
  const int tok0 = chunk * 128;
  const int rowA = tok0 + wave * 32 + cl;

    const int hq = unit - 10, kv = hq / 3;
    const int cs = chunk < 128 ? (chunk & 63) : ((chunk - 128) & 15), ncs = chunk < 128 ? 64 : 16;
    const float sink = p.sink[l * 6 + hq];
    bf16x8 afr[4];
#pragma unroll
    for (int s = 0; s < 4; ++s) afr[s] = *(const bf16x8*)(proj + (size_t)rowA * IN_DIM + 2048 + hq * 64 + s * 16 + hh * 8);
    float mrow = sink, lrow = 0.f;
    f32x16 O[2]; O[0] = zero16(); O[1] = zero16();
    u32x4 kr[2], vr[2];
    const bf16_t* kvp = proj + (size_t)(tok0 - 128) * IN_DIM + 2432 + kv * 64;
    if (cs > 0) { ldg_rows(kr, kvp, IN_DIM); ldg_rowsT(vr, kvp + 128, IN_DIM); }
    for (int kb = 0; kb < 6; ++kb) {
      const int kc = cs + (kb >> 1) - 1, kcn = cs + ((kb + 1) >> 1) - 1;
      const bool kvalid = kc >= 0 && kc < ncs;
      __syncthreads();
      if (kvalid) { sts_rows(sK, kr); sts_T_raw(sV, vr); }
      __syncthreads();
      if (kb < 5 && kcn >= 0 && kcn < ncs) {
        ldg_rows(kr, kvp + (size_t)(kb + 1) * 64 * IN_DIM, IN_DIM); ldg_rowsT(vr, kvp + (size_t)(kb + 1) * 64 * IN_DIM + 128, IN_DIM);
      }
      if (!kvalid) continue;
      if ((kb == 0 && wave >= 2) || (kb == 5 && wave < 2)) continue;
      const bool need_mask = (kb < 2) || (kb > 3);
      f32x16 X[2]; X[0] = zero16(); X[1] = zero16();
#pragma unroll
      for (int s = 0; s < 4; ++s)
#pragma unroll
        for (int tk = 0; tk < 2; ++tk) {
          const bf16x8 a = *(const bf16x8*)(sK + (tk * 32 + cl) * 72 + s * 16 + hh * 8);
          X[tk] = mfma32(a, afr[s], X[tk]);
        }
      int dbase = kb * 64 - 128 + 4 * hh - wave * 32 - cl;
      asm volatile("" : "+v"(dbase));
      float mx = -1e30f;
#pragma unroll
      for (int tk = 0; tk < 2; ++tk)
#pragma unroll
        for (int reg = 0; reg < 16; ++reg) {
          const int dd = dbase + tk * 32 + (reg & 3) + 8 * (reg >> 2);
          const float sv = (!need_mask || (dd <= 128 && dd >= -128)) ? X[tk][reg] : -1e30f;
          X[tk][reg] = sv;
          mx = fmaxf(mx, sv);
        }
      mx = fmaxf(mx, __shfl_xor(mx, 32));
      const float mn = fmaxf(mrow, mx);
      const float alpha = __expf(mrow - mn);
      mrow = mn;
      float psum = 0.f;
#pragma unroll
      for (int tk = 0; tk < 2; ++tk)
#pragma unroll
        for (int reg = 0; reg < 16; ++reg) { const float pv = __expf(X[tk][reg] - mn); X[tk][reg] = pv; psum += pv; }
      lrow = lrow * alpha + psum;
#pragma unroll
      for (int reg = 0; reg < 16; ++reg) { O[0][reg] *= alpha; O[1][reg] *= alpha; }
#pragma unroll
      for (int tk = 0; tk < 2; ++tk)
#pragma unroll
        for (int s2 = 0; s2 < 2; ++s2) {
          u32x4 pb;
          pb.x = pack2(X[tk][8 * s2 + 0], X[tk][8 * s2 + 1]); pb.y = pack2(X[tk][8 * s2 + 2], X[tk][8 * s2 + 3]);
          pb.z = pack2(X[tk][8 * s2 + 4], X[tk][8 * s2 + 5]); pb.w = pack2(X[tk][8 * s2 + 6], X[tk][8 * s2 + 7]);
          const bf16x8 bfrag = __builtin_bit_cast(bf16x8, pb);
#pragma unroll
          for (int te = 0; te < 2; ++te) {
            const bf16_t* vp = sV + (te * 32 + cl) * 72 + tk * 32 + s2 * 16 + 4 * hh;
            const u32x2 v0 = *(const u32x2*)vp, v1 = *(const u32x2*)(vp + 8);
            u32x4 va; va.x = v0.x; va.y = v0.y; va.z = v1.x; va.w = v1.y;
            O[te] = mfma32(__builtin_bit_cast(bf16x8, va), bfrag, O[te]);
          }
        }
    }
    {
      const float den = lrow + __shfl_xor(lrow, 32) + __expf(sink - mrow);
      const float inv = 1.f / den;
      wave_lds_fence();
#pragma unroll
      for (int te = 0; te < 2; ++te)
#pragma unroll
        for (int g4 = 0; g4 < 4; ++g4) {
          u32x2 o2;
          o2.x = pack2(O[te][4 * g4 + 0] * inv, O[te][4 * g4 + 1] * inv); o2.y = pack2(O[te][4 * g4 + 2] * inv, O[te][4 * g4 + 3] * inv);
          *(u32x2*)(sP + cl * 72 + te * 32 + 8 * g4 + 4 * hh) = o2;
        }
    }
    tile_store(ymix + (size_t)(tok0 + wave * 32) * D + 640 + hq * 64, D, sP, lane);
}

#ifndef PANEL_H
#define PANEL_H 4
#endif
__device__ __forceinline__ bool xcd_tile(int w, int MT, int NT, int& mt, int& nt) {
  const int x = blockIdx.x & 7;
  const int nq = (MT - x + 7) >> 3;
  const int per_panel = PANEL_H * NT, pi = w / per_panel, idx = w - pi * per_panel;
  const int rows = nq - pi * PANEL_H < PANEL_H ? nq - pi * PANEL_H : PANEL_H;
  if (rows <= 0) return false;
  nt = idx / rows;
  const int mq = idx - nt * rows;
  if (nt >= NT) return false;
  mt = x + 8 * (pi * PANEL_H + mq);
  return mt < MT;
}
__device__ __forceinline__ void run_phase(const Params& p, int ph, unsigned char* lds) {
  const int G = gridDim.x, bid = blockIdx.x;
  const int half = __builtin_amdgcn_readfirstlane(tid_() >> 8), sb = bid * 2 + half, SG = G * 2;
  unsigned char* slds = lds + half * LDS_BYTES;
  if (ph == 0) { phase_setup(p, lds); return; }
  if (ph == 1) { phase_norm(p, 0, 0); return; }
  const int l = (ph - 2) / 9, s = (ph - 2) % 9;
  const unsigned char* wl = p.ws + SZ_WLAYER * l;
  const bf16_t* hbuf = (const bf16_t*)(p.ws + OFF_RA);
  const int xg = G >> 3;
#define GEMM_UNITS(MODE_, WMAX, MT_, NT_, A_, B_, K_, OUT_)                                                             \
  {                                                                                                               \
    int w = bid >> 3, mt, nt; bool first = true;                                                                  \
    while (w < (WMAX) && !xcd_tile(w, MT_, NT_, mt, nt)) w += xg;                                                 \
    while (w < (WMAX)) {                                                                                          \
      int w2 = w + xg, mt2 = 0, nt2 = 0;                                                                          \
      while (w2 < (WMAX) && !xcd_tile(w2, MT_, NT_, mt2, nt2)) w2 += xg;                                          \
      if (MODE_ == 1 && nt == 10) gemm256<MODE_, true>(p, l, mt, nt, A_, B_, K_, first, w2 < (WMAX), mt2, nt2, OUT_);                \
      else gemm256<MODE_>(p, l, mt, nt, A_, B_, K_, first, w2 < (WMAX), mt2, nt2, OUT_);                                   \
      first = false; w = w2; mt = mt2; nt = nt2;                                                                  \
    }                                                                                                             \
  }
  switch (s) {
    case 0: GEMM_UNITS(1, 24 * 11, 192, 11, hbuf, (const bf16_t*)(wl + OFF_WIN), D, OFF_RB) break;
    case 1:
      {
        int it = sb;
        for (; it < NCH * 6; it += SG) r1_item(p, l, it / 6, it % 6, slds);
        for (; it < NCH * 12; it += SG) { const int i2 = it - NCH * 6; mix_att(p, l, i2 / 6, 10 + i2 % 6, slds); }
      }
      break;
    case 2: phase_scan(p, l); break;
    case 3:
      {
        int it = sb;
        for (; it < NCH * 6; it += SG) mix_ret(p, l, it / 6, 4 + it % 6, slds);
        for (; it < NCH * 10; it += SG) { const int i2 = it - NCH * 6; mix_sgu(p, l, i2 >> 2, i2 & 3, slds); }
      }
      break;
    case 4: GEMM_UNITS(2, 24 * 4, 192, 4, hbuf, (const bf16_t*)(wl + OFF_WOUT), D, OFF_RC) break;
    case 5: phase_norm(p, l, 1); break;
    case 6: GEMM_UNITS(3, 28 * 22, 202, 22, hbuf, (const bf16_t*)(wl + OFF_WUP), D, OFF_RB) break;
    case 7: GEMM_UNITS(2, 24 * 4, 192, 4, (const bf16_t*)(p.ws + OFF_RB), (const bf16_t*)(wl + OFF_WDOWN), DFF, OFF_RA) break;
    default: phase_norm(p, l, 2); break;
  }
#undef GEMM_UNITS
}

#define XB_TMO      128
#define XB_XCNT(j)  (256  + 64 * (j))
#define XB_XSUB(j)  (1280 + 64 * (j))
#define XB_XGEN(j)  (2304 + 64 * (j))
#define XB_TOP      3328
#define XB_TOPGEN   3392
#define XB_SPIN_CAP (1u << 18)
#define LAS __attribute__((address_space(3)))
__device__ __forceinline__ unsigned xb_ld(unsigned* p)              { return __hip_atomic_load(p, __ATOMIC_RELAXED, __HIP_MEMORY_SCOPE_AGENT); }
__device__ __forceinline__ unsigned xb_add(unsigned* p, unsigned v) { return __hip_atomic_fetch_add(p, v, __ATOMIC_RELAXED, __HIP_MEMORY_SCOPE_AGENT); }
__device__ __forceinline__ unsigned xb_xcc_id() { return (unsigned)__builtin_amdgcn_s_getreg((3 << 11) | 20) & 0xFu; }
#define XB_SPIN(cond, bar) do { unsigned _sp = 0; while (cond) { __builtin_amdgcn_s_sleep(1); \
    if ((++_sp & 255u) == 0u) { if (xb_ld(&(bar)[XB_TMO])) break; if (_sp > XB_SPIN_CAP) { atomicAdd(&(bar)[XB_TMO], 1u); break; } } } } while (0)
__device__ __forceinline__ void xcd_barrier_complete(unsigned* bar, unsigned x, unsigned& nloc, unsigned& nx) {
  const unsigned G = gridDim.x;
  unsigned sum, cnt, mine, sp = 0u;
  for (;;) {
    sum = 0u; cnt = 0u; mine = 0u;
#pragma unroll
    for (unsigned j = 0; j < 16; ++j) { const unsigned c = xb_ld(&bar[XB_XCNT(j)]); sum += c; cnt += (c > 0u) ? 1u : 0u; mine = (j == x) ? c : mine; }
    if (sum == G) break;
    __builtin_amdgcn_s_sleep(1);
    if ((++sp & 255u) == 0u) { if (xb_ld(&bar[XB_TMO])) break; if (sp > XB_SPIN_CAP) { atomicAdd(&bar[XB_TMO], 1u); break; } }
  }
  nloc = mine > 0u ? mine : 1u; nx = cnt > 0u ? cnt : 1u;
}
__device__ __forceinline__ void grid_bar(unsigned* bar, volatile LAS unsigned* st) {
  asm volatile("s_waitcnt vmcnt(0)" ::: "memory");
  __syncthreads();
  if (threadIdx.x == 0) {
    __builtin_amdgcn_s_waitcnt(0);
    const unsigned x = xb_xcc_id();
    unsigned nloc = st[0], nx = st[1];
    if (nloc == 0u) { xcd_barrier_complete(bar, x, nloc, nx); st[0] = nloc; st[1] = nx; }
    const unsigned old = xb_add(&bar[XB_XSUB(x)], 1u);
    const unsigned gen = old / nloc;
    if (old + 1u == (gen + 1u) * nloc) {
      __builtin_amdgcn_fence(__ATOMIC_RELEASE, "agent");
      asm volatile("s_waitcnt vmcnt(0)" ::: "memory");
      const unsigned og = xb_add(&bar[XB_TOP], 1u);
      const unsigned tg = og / nx;
      if (og + 1u == (tg + 1u) * nx) xb_add(&bar[XB_TOPGEN], 1u);
      else XB_SPIN(xb_ld(&bar[XB_TOPGEN]) == tg, bar);
      __builtin_amdgcn_fence(__ATOMIC_ACQUIRE, "agent");
      xb_add(&bar[XB_XGEN(x)], 1u);
      asm volatile("s_waitcnt vmcnt(0)" ::: "memory");
    } else {
      XB_SPIN(xb_ld(&bar[XB_XGEN(x)]) == gen, bar);
      __builtin_amdgcn_fence(__ATOMIC_ACQUIRE, "agent");
      asm volatile("s_waitcnt vmcnt(0)" ::: "memory");
    }
  }
  __syncthreads();
}
typedef const float* cfp_t;
typedef const cfp_t __attribute__((address_space(4)))* kargp_t;
__device__ __forceinline__ void run_phase_fresh(int ph, unsigned char* lds) {
  kargp_t q = (kargp_t)__builtin_amdgcn_kernarg_segment_ptr();
  asm volatile("" : "+s"(q));
  Params lp;
  lp.xp = q[0];
  lp.xs = q[1];
  lp.cp = q[2];
  lp.cs = q[3];
  lp.w_ada = q[4];
  lp.b_ada = q[5];
  lp.g_pre_mix = q[6];
  lp.g_post_mix = q[7];
  lp.g_pre_ffn = q[8];
  lp.g_post_ffn = q[9];
  lp.w_in = q[10];
  lp.sgu_norm = q[11];
  lp.sgu_w = q[12];
  lp.sgu_b = q[13];
  lp.dec_f = q[14];
  lp.dec_b = q[15];
  lp.sink = q[16];
  lp.w_out = q[17];
  lp.w_up = q[18];
  lp.conv_w = q[19];
  lp.conv_b = q[20];
  lp.w_down = q[21];
  lp.out = (float*)q[22];
  lp.ws = (unsigned char*)q[23];
  run_phase(lp, ph, lds);
}
__global__ void __launch_bounds__(512, 2) mega_kernel(Params p, int ph_lo, int ph_hi) {
  unsigned char* lds = dyn_lds;
  cg::grid_group grid = cg::this_grid();
#if N_LAUNCH_MODE == 1
  unsigned* bar = (unsigned*)((unsigned char*)((kargp_t)__builtin_amdgcn_kernarg_segment_ptr())[23] + OFF_BAR);
  __shared__ u32x4 xb_words;
  if (threadIdx.x == 0) xb_words = u32x4{0u, 0u, 0u, 0u};
  __syncthreads();
  volatile LAS unsigned* st = (volatile LAS unsigned*)&xb_words;
  if (threadIdx.x == 0) (void)xb_add(&bar[XB_XCNT(xb_xcc_id())], 1u);
  run_phase_fresh(0, lds); grid.sync();
#ifdef REP0
  run_phase_fresh(0, lds); grid.sync(); run_phase_fresh(0, lds); grid.sync();
#endif
  run_phase_fresh(1, lds); grid_bar(bar, st);
#ifdef STOP_PH
#define PHS(n) if (n <= STOP_PH) { run_phase_fresh(n, lds); grid.sync(); }
#elif defined(REP_PH)
#define PHS(n) run_phase_fresh(n, lds); grid.sync(); if (n == REP_PH) { run_phase_fresh(n, lds); grid.sync(); run_phase_fresh(n, lds); grid.sync(); }
#elif defined(REP_S)
#define PHS(n) run_phase_fresh(n, lds); grid.sync(); if (n >= 2 && (n - 2) % 9 == REP_S) { run_phase_fresh(n, lds); grid.sync(); }
#elif defined(SYNC2)
#define PHS(n) run_phase_fresh(n, lds); grid.sync(); grid.sync(); grid.sync();
#else
#define PHS(n) run_phase_fresh(n, lds); grid_bar(bar, st);
#endif
  PHS(2) PHS(3) PHS(4) PHS(5) PHS(6) PHS(7) PHS(8) PHS(9) PHS(10)
  PHS(11) PHS(12) PHS(13) PHS(14) PHS(15) PHS(16) PHS(17) PHS(18)
#ifdef STOP_PH
  {
    kargp_t q = (kargp_t)__builtin_amdgcn_kernarg_segment_ptr();
    float* o = (float*)q[22]; const bf16_t* b = (const bf16_t*)((const unsigned char*)q[23] + DUMP_OFF);
    for (size_t i = (size_t)blockIdx.x * 256 + threadIdx.x; i < (size_t)T * D; i += (size_t)gridDim.x * 256) o[i] = (i < DUMP_N) ? bf2f(b[i]) : 0.f;
  }
#else
  run_phase_fresh(19, lds);
#endif
  static_assert(NPHASE == 20, "phase list");
#else
  if (ph_lo == 100) {
    float* o = p.out; const float* b = (const float*)(p.ws + DUMP_OFF);
    for (size_t i = (size_t)blockIdx.x * 256 + threadIdx.x; i < (size_t)T * D; i += (size_t)gridDim.x * 256) o[i] = (i < DUMP_N) ? b[i] : 0.f;
    return;
  }
  for (int ph = ph_lo; ph < ph_hi; ++ph) run_phase(p, ph, lds);
#endif
}

extern "C" void kernel_launch(void* const* d_in, const int* in_sizes, int n_in, void* d_out, int out_size, void* d_ws, size_t ws_size,
                              hipStream_t stream) {
  static int grid_blocks = 0;
  if (!grid_blocks) {
    int dev = 0, cus = 0, per_cu = 0;
    hipGetDevice(&dev);
    hipDeviceGetAttribute(&cus, hipDeviceAttributeMultiprocessorCount, dev);
    hipFuncSetAttribute((const void*)mega_kernel, hipFuncAttributeMaxDynamicSharedMemorySize, DYN_LDS);
    hipOccupancyMaxActiveBlocksPerMultiprocessor(&per_cu, (const void*)mega_kernel, 512, DYN_LDS);
    if (per_cu > 1) per_cu = 1;
    if (per_cu < 1) per_cu = 1;
    grid_blocks = cus * per_cu;
  }
  if (ws_size < WS_NEED || n_in != 22) { fprintf(stderr, "kernel_launch: workspace too small (%zu < %zu) or n_in %d\n", ws_size, (size_t)WS_END, n_in); return; }
  Params p{};
  const float** pp = (const float**)&p;
  for (int i = 0; i < 22; ++i) pp[i] = (const float*)d_in[i];
  p.out = (float*)d_out;
  p.ws = (unsigned char*)d_ws;
#if N_LAUNCH_MODE == 1
  hipMemsetAsync((unsigned char*)d_ws + OFF_BAR, 0, BAR_BYTES, stream);
  int lo = 0, hi = NPHASE;
  void* args[] = {&p, &lo, &hi};
  hipError_t e = hipLaunchCooperativeKernel((const void*)mega_kernel, dim3(grid_blocks), dim3(512), args, DYN_LDS, stream);
  if (e != hipSuccess) fprintf(stderr, "cooperative launch failed: %s (grid %d)\n", hipGetErrorString(e), grid_blocks);
#else
#ifdef STOP_PH
  for (int ph = 0; ph <= STOP_PH; ++ph) hipLaunchKernelGGL(mega_kernel, dim3(grid_blocks), dim3(512), DYN_LDS, stream, p, ph, ph + 1);
  hipLaunchKernelGGL(mega_kernel, dim3(grid_blocks), dim3(512), DYN_LDS, stream, p, 100, 101);
#else
  for (int ph = 0; ph < NPHASE; ++ph) hipLaunchKernelGGL(mega_kernel, dim3(grid_blocks), dim3(512), DYN_LDS, stream, p, ph, ph + 1);
#endif
#endif
}
```
